# Optimizing an MI355X kernel written in HIP

```python
import jax, jax.numpy as jnp
from jax import lax
import numpy as np

D_MODEL = 2048
BATCH = 2
SEQ = 4096
DEPTH = 1

CHUNK = 64
SGU_BLOCK = 128
D_SGU = D_MODEL // 2
SGU_HEADS = 8
SGU_HEAD_DIM = D_SGU // SGU_HEADS
D_POOL = D_MODEL // 2
POOL_WINDOWS = (2, 4, 8, 16)
POOL_GROUPS = len(POOL_WINDOWS)
POOL_GROUP_DIM = D_POOL // POOL_GROUPS
D_FF = -(-8 * D_MODEL // (3 * 256)) * 256
D_IN = 2 * D_SGU + D_POOL + 2 * D_MODEL
EPS = 1e-6

kernel_name = "hybrid_sgu_pool_gated_block"


def rms_norm(x, g):
    xf = x.astype(jnp.float32)
    y = xf * lax.rsqrt(jnp.mean(xf * xf, axis=-1, keepdims=True) + EPS)
    return (y * g.astype(jnp.float32)).astype(x.dtype)


def layer_norm(x, g, b):
    xf = x.astype(jnp.float32)
    mu = jnp.mean(xf, axis=-1, keepdims=True)
    xc = xf - mu
    y = xc * lax.rsqrt(jnp.mean(xc * xc, axis=-1, keepdims=True) + EPS)
    return (y * g.astype(jnp.float32) + b.astype(jnp.float32)).astype(x.dtype)


def sgu_mixer(u, v, ln_g, ln_b, w_s, b_s):
    bsz, s, _ = v.shape
    nb = s // SGU_BLOCK
    v = layer_norm(v, ln_g, ln_b)
    idx = jnp.arange(SGU_BLOCK)
    mask = (idx[:, None] // CHUNK) >= (idx[None, :] // CHUNK)
    w = jnp.where(mask[None], w_s, 0)
    vb = v.reshape(bsz, nb, SGU_BLOCK, SGU_HEADS, SGU_HEAD_DIM)
    mixed = jnp.einsum('hij,bnjhd->bnihd', w, vb) + b_s.T[None, None, :, :, None]
    return u * mixed.reshape(bsz, s, D_SGU)


def pool_mixer(p, w_pool, scale):
    bsz, s, _ = p.shape
    pf = p.astype(jnp.float32)
    c = jnp.cumsum(pf, axis=1)
    count = jnp.arange(1, s + 1, dtype=jnp.float32)
    means = []
    for gi, w in enumerate(POOL_WINDOWS):
        cg = c[..., gi * POOL_GROUP_DIM:(gi + 1) * POOL_GROUP_DIM]
        lag = jnp.pad(cg[:, :s - w], ((0, 0), (w, 0), (0, 0)))
        means.append((cg - lag) / jnp.minimum(count, w)[None, :, None])
    pooled = (jnp.concatenate(means, axis=-1) - pf).astype(p.dtype)
    pooled = pooled.reshape(bsz, s, POOL_GROUPS, POOL_GROUP_DIM)
    y = jnp.einsum('bsgc,gcd->bsgd', pooled, w_pool).reshape(bsz, s, D_POOL)
    return y * scale


def setup_inputs(seed: int = 0) -> dict:
    key = jax.random.key(seed)
    ks = jax.random.split(key, 20)
    f32 = jnp.float32

    def nrm(k, shape, fan_in):
        return jax.random.normal(k, shape, f32) * (fan_in ** -0.5)

    def gain(k, shape):
        return 1.0 + 0.02 * jax.random.normal(k, shape, f32)

    L = DEPTH
    return {
        "x": jax.random.normal(ks[0], (BATCH, SEQ, D_MODEL), f32),
        "norm1_pre": gain(ks[1], (L, D_MODEL)),
        "w_in": nrm(ks[2], (L, D_MODEL, D_IN), D_MODEL),
        "v_ln_g": gain(ks[3], (L, D_SGU)),
        "v_ln_b": 0.02 * jax.random.normal(ks[4], (L, D_SGU), f32),
        "sgu_w": nrm(ks[5], (L, SGU_HEADS, SGU_BLOCK, SGU_BLOCK), SGU_BLOCK),
        "sgu_b": gain(ks[6], (L, SGU_HEADS, SGU_BLOCK)),
        "pool_w": nrm(ks[7], (L, POOL_GROUPS, POOL_GROUP_DIM, POOL_GROUP_DIM), POOL_GROUP_DIM),
        "pool_scale": gain(ks[8], (L, D_POOL)),
        "w_a_out": nrm(ks[9], (L, D_SGU, D_MODEL), D_SGU),
        "w_b_out": nrm(ks[10], (L, D_POOL, D_MODEL), D_POOL),
        "w_mix_out": nrm(ks[11], (L, D_MODEL, D_MODEL), D_MODEL),
        "norm1_post": gain(ks[12], (L, D_MODEL)),
        "norm2_pre": gain(ks[13], (L, D_MODEL)),
        "w_ffn_gate": nrm(ks[14], (L, D_MODEL, D_FF), D_MODEL),
        "w_ffn_up": nrm(ks[15], (L, D_MODEL, D_FF), D_MODEL),
        "w_ffn_down": nrm(ks[16], (L, D_FF, D_MODEL), D_FF),
        "norm2_post": gain(ks[17], (L, D_MODEL)),
    }


def reference(x, norm1_pre, w_in, v_ln_g, v_ln_b, sgu_w, sgu_b, pool_w, pool_scale,
              w_a_out, w_b_out, w_mix_out, norm1_post, norm2_pre, w_ffn_gate,
              w_ffn_up, w_ffn_down, norm2_post):
    s1 = D_SGU
    s2 = 2 * D_SGU
    s3 = s2 + D_POOL
    s4 = s3 + D_MODEL
    for l in range(DEPTH):
        h = rms_norm(x, norm1_pre[l])
        z = jnp.einsum('bsd,de->bse', h, w_in[l])
        uv = jax.nn.gelu(z[..., :s2], approximate=False)
        u, v = uv[..., :s1], uv[..., s1:]
        p = z[..., s2:s3]
        gate_a = jax.nn.sigmoid(z[..., s3:s4])
        gate_b = jax.nn.sigmoid(z[..., s4:])
        y_a = sgu_mixer(u, v, v_ln_g[l], v_ln_b[l], sgu_w[l], sgu_b[l])
        y_b = pool_mixer(p, pool_w[l], pool_scale[l])
        merged = (gate_a * jnp.einsum('bsc,cd->bsd', y_a, w_a_out[l])
                  + gate_b * jnp.einsum('bsc,cd->bsd', y_b, w_b_out[l]))
        mix_out = jnp.einsum('bsd,de->bse', merged, w_mix_out[l])
        x = x + rms_norm(mix_out, norm1_post[l])
        h = rms_norm(x, norm2_pre[l])
        hid = (jax.nn.silu(jnp.einsum('bsd,df->bsf', h, w_ffn_gate[l]))
               * jnp.einsum('bsd,df->bsf', h, w_ffn_up[l]))
        ffn_out = jnp.einsum('bsf,fd->bsd', hid, w_ffn_down[l])
        x = x + rms_norm(ffn_out, norm2_post[l])
    return x
```

```cpp
#ifndef PROBE_REP
#define PROBE_REP -1
#endif
#include <hip/hip_runtime.h>
#include <hip/hip_cooperative_groups.h>
#include <cstdio>
#include <cstdint>
namespace cg = cooperative_groups;
#define LAS __attribute__((address_space(3)))
#define XB_TMO      128
#define XB_XCNT(j)  (256  + 64 * (j))
#define XB_XSUB(j)  (1280 + 64 * (j))
#define XB_XGEN(j)  (2304 + 64 * (j))
#define XB_TOP      3328
#define XB_TOPGEN   3392
#define XCD_BAR_WORDS 3456
#define XB_SPIN_CAP (1u << 18)

__device__ __forceinline__ unsigned xb_ld(unsigned* p)              { return __hip_atomic_load(p, __ATOMIC_RELAXED, __HIP_MEMORY_SCOPE_AGENT); }
__device__ __forceinline__ unsigned xb_add(unsigned* p, unsigned v) { return __hip_atomic_fetch_add(p, v, __ATOMIC_RELAXED, __HIP_MEMORY_SCOPE_AGENT); }
__device__ __forceinline__ unsigned xb_xcc_id() { return (unsigned)__builtin_amdgcn_s_getreg((3 << 11) | 20) & 0xFu; }
#define XB_SPIN(cond, bar) do { unsigned _sp = 0; while (cond) { __builtin_amdgcn_s_sleep(1); \
    if ((++_sp & 255u) == 0u) { if (xb_ld(&(bar)[XB_TMO])) break; if (_sp > XB_SPIN_CAP) { atomicAdd(&(bar)[XB_TMO], 1u); break; } } } } while (0)

struct XcdBarrier {
    unsigned* bar; unsigned x;
    volatile LAS unsigned* st;
};

__device__ __forceinline__ XcdBarrier xcd_barrier_post(unsigned* bar, volatile LAS unsigned* st) {
    XcdBarrier b; b.bar = bar; b.x = xb_xcc_id(); b.st = st;
    if (threadIdx.x == 0) (void)xb_add(&bar[XB_XCNT(b.x)], 1u);
    return b;
}
__device__ __forceinline__ void xcd_barrier_complete(unsigned* bar, unsigned x, unsigned& nloc, unsigned& nx) {
    const unsigned G = gridDim.x * gridDim.y * gridDim.z;
    unsigned sum, cnt, mine, sp = 0u;
    for (;;) {
        sum = 0u; cnt = 0u; mine = 0u;
#pragma unroll
        for (unsigned j = 0; j < 16; ++j) { const unsigned c = xb_ld(&bar[XB_XCNT(j)]); sum += c; cnt += (c > 0u) ? 1u : 0u; mine = (j == x) ? c : mine; }
        if (sum == G) break;
        __builtin_amdgcn_s_sleep(1);
        if ((++sp & 255u) == 0u) { if (xb_ld(&bar[XB_TMO])) break; if (sp > XB_SPIN_CAP) { atomicAdd(&bar[XB_TMO], 1u); break; } }
    }
    nloc = mine > 0u ? mine : 1u; nx = cnt > 0u ? cnt : 1u;
}

__device__ __forceinline__ void xcd_barrier(const XcdBarrier& b) {
    asm volatile("s_waitcnt vmcnt(0)" ::: "memory");
    __syncthreads();
    if (threadIdx.x == 0) {
        unsigned* bar = b.bar;
        __builtin_amdgcn_s_waitcnt(0);
        unsigned nloc = b.st[0], nx = b.st[1];
        if (nloc == 0u) { xcd_barrier_complete(bar, b.x, nloc, nx); b.st[0] = nloc; b.st[1] = nx; }
        const unsigned old = xb_add(&bar[XB_XSUB(b.x)], 1u);
        const unsigned gen = old / nloc;
        if (old + 1u == (gen + 1u) * nloc) {
            __builtin_amdgcn_fence(__ATOMIC_RELEASE, "agent");
            asm volatile("s_waitcnt vmcnt(0)" ::: "memory");
            const unsigned og = xb_add(&bar[XB_TOP], 1u);
            const unsigned tg = og / nx;
            if (og + 1u == (tg + 1u) * nx) xb_add(&bar[XB_TOPGEN], 1u);
            else XB_SPIN(xb_ld(&bar[XB_TOPGEN]) == tg, bar);
            __builtin_amdgcn_fence(__ATOMIC_ACQUIRE, "agent");
            xb_add(&bar[XB_XGEN(b.x)], 1u);
            asm volatile("s_waitcnt vmcnt(0)" ::: "memory");
        } else {
            XB_SPIN(xb_ld(&bar[XB_XGEN(b.x)]) == gen, bar);
            __builtin_amdgcn_fence(__ATOMIC_ACQUIRE, "agent");
            asm volatile("s_waitcnt vmcnt(0)" ::: "memory");
        }
    }
    __syncthreads();
}


template <bool ACQ>
__device__ __forceinline__ void panel_barrier(unsigned* word, unsigned* tmo) {
    asm volatile("s_waitcnt vmcnt(0)" ::: "memory");
    __syncthreads();
    if (threadIdx.x == 0) {
        (void)xb_add(word, 1u);
        unsigned sp = 0;
        while (xb_ld(word) < 8u) { __builtin_amdgcn_s_sleep(1); if ((++sp & 255u) == 0u) { if (xb_ld(tmo)) break; if (sp > XB_SPIN_CAP) { atomicAdd(tmo, 1u); break; } } }
        if (ACQ) { __builtin_amdgcn_fence(__ATOMIC_ACQUIRE, "agent"); asm volatile("s_waitcnt vmcnt(0)" ::: "memory"); }
    }
    __syncthreads();
}
typedef unsigned wt_u32x4 __attribute__((ext_vector_type(4)));
typedef unsigned wt_u32x2 __attribute__((ext_vector_type(2)));
__device__ __forceinline__ void st16_wt(void* p, wt_u32x4 v) { asm volatile("global_store_dwordx4 %0, %1, off sc1\n\ts_nop 1" : : "v"(p), "v"(v) : "memory"); }
__device__ __forceinline__ void st8_wt(void* p, wt_u32x2 v) { asm volatile("global_store_dwordx2 %0, %1, off sc1" : : "v"(p), "v"(v) : "memory"); }
namespace pg8 {
#define PG8_LAS __attribute__((address_space(3)))
typedef unsigned short bf16_t;
typedef short bf16x8 __attribute__((ext_vector_type(8)));
typedef float f32x4 __attribute__((ext_vector_type(4)));
typedef unsigned u32x4 __attribute__((ext_vector_type(4)));
constexpr int BM = 256, BK = 64, HALF = 128, HTB = HALF * BK * 2  , STAGE_BYTES = 8 * HTB, NXCD = 8, WGM = 8;

__host__ __device__ __forceinline__ int lds_byte(int r, int c) { const int st = (r >> 4) * 2 + (c >> 5), rr = r & 15, cc = c & 31, ob = rr * 64 + cc * 2; return st * 1024 + (ob ^ (((ob >> 9) & 1) << 5)); }
__host__ __device__ __forceinline__ void stage_rc(int b, int& R, int& C) { const int st = b / 1024, sb = b % 1024, swz = sb ^ (((sb >> 9) & 1) << 5); R = (st >> 1) * 16 + swz / 64; C = (st & 1) * 32 + (swz % 64) / 2; }
__host__ __device__ __forceinline__ int perm32(int rho) { const int n = rho >> 4, i = rho & 15; return 8 * (i >> 2) + 4 * n + (i & 3); }

struct Unit { int pm, pn, z; };
struct Gemm { const bf16_t *A0, *A1, *B0, *B1; int M, N, K; };

struct StaticOrder {
    int nM, nN, nwg, G, c;
    __host__ __device__ void init(int M, int N, int G_, int c_) { nM = M / BM; nN = N / BM; nwg = nM * nN; G = G_; c = c_; }
    __host__ __device__ bool next(int i, Unit& u) const {
        const long L = (long)i * G + c; if (L >= nwg) return false;
        int wgid = (int)L; { const int q = nwg / NXCD, r = nwg % NXCD, xcd = wgid % NXCD, off = wgid / NXCD; wgid = (xcd < r ? xcd * (q + 1) : r * (q + 1) + (xcd - r) * q) + off; }
        const int nig = WGM * nN, gid = wgid / nig, fm = gid * WGM, gsz = (nM - fm) < WGM ? (nM - fm) : WGM;
        u.pm = fm + ((wgid % nig) % gsz); u.pn = (wgid % nig) / gsz; u.z = 0; return true;
    }
    __device__ __forceinline__ void a_ready(const Unit&) const {}
    __device__ __forceinline__ void done(const Unit&) const {}
};

typedef float f32x2 __attribute__((ext_vector_type(2)));
typedef unsigned u32x2 __attribute__((ext_vector_type(2)));
__device__ __forceinline__ unsigned cvt_pk_bf16(float lo, float hi) { unsigned r; asm volatile("v_cvt_pk_bf16_f32 %0, %1, %2" : "=v"(r) : "v"(lo), "v"(hi)); return r; }
__device__ __forceinline__ float bf_lo(unsigned w) { return __uint_as_float(w << 16); }
__device__ __forceinline__ float bf_hi(unsigned w) { return __uint_as_float(w & 0xffff0000u); }
__device__ __forceinline__ f32x2 gelu_pk(f32x2 v) {
    const f32x2 av = __builtin_elementwise_abs(v), d = av * 0.2316418882f + 1.0f;
    f32x2 t; t.x = __builtin_amdgcn_rcpf(d.x); t.y = __builtin_amdgcn_rcpf(d.y);
    f32x2 q = t * 0.5307027145f + (-0.7265760135f); q = q * t + 0.7107068705f; q = q * t + (-0.142248368f); q = q * t + 0.127414796f; q = q * t;
    const f32x2 s = (v * v) * (-0.72134752044f);
    f32x2 e; e.x = __builtin_amdgcn_exp2f(s.x); e.y = __builtin_amdgcn_exp2f(s.y);
    const f32x2 m = v * (q * e), r = v - m;
    f32x2 o; o.x = v.x < 0.f ? m.x : r.x; o.y = v.y < 0.f ? m.y : r.y; return o;
}
__device__ __forceinline__ f32x4 gelu4(f32x4 v) { f32x2 a = gelu_pk((f32x2){v[0], v[1]}), b = gelu_pk((f32x2){v[2], v[3]}); return (f32x4){a.x, a.y, b.x, b.y}; }
__device__ __forceinline__ float exp_neg(float x) { return __builtin_amdgcn_exp2f(fminf(-x * 1.44269504089f, 100.f)); }
__device__ __forceinline__ float ld_agent(const float* p) { return __hip_atomic_load(p, __ATOMIC_RELAXED, __HIP_MEMORY_SCOPE_AGENT); }
__device__ __forceinline__ u32x4 pack8(f32x4 a, f32x4 b) { u32x4 w; w.x = cvt_pk_bf16(a[0], a[1]); w.y = cvt_pk_bf16(a[2], a[3]); w.z = cvt_pk_bf16(b[0], b[1]); w.w = cvt_pk_bf16(b[2], b[3]); return w; }
__device__ __forceinline__ void unpack8(u32x4 w, f32x4& a, f32x4& b) { a = (f32x4){bf_lo(w.x), bf_hi(w.x), bf_lo(w.y), bf_hi(w.y)}; b = (f32x4){bf_lo(w.z), bf_hi(w.z), bf_lo(w.w), bf_hi(w.w)}; }

constexpr int D_ = 2048, DS_ = 1024, FF_ = 5632;
constexpr float EPS_ = 1e-6f;
struct EpiIn {
    static constexpr bool PERM = true, AFTER_DRAIN = false, KEEP = false;
    bf16_t *UV, *P, *R, *GB; float *vsum, *vsq;
    __device__ __forceinline__ void operator()(f32x4 (&acc)[2][2][4][2], const Unit& u, int wr, int wc, int fr, int fq) const {
        const int row0 = u.pm * BM + wr * 64 + fr, cl = wc * 32 + 8 * fq;
        if (u.pn < 8) {
            const bool isv = u.pn >= 4;
#pragma unroll
            for (int ai = 0; ai < 2; ++ai)
#pragma unroll
                for (int m = 0; m < 4; ++m) { const int row = row0 + ai * HALF + m * 16; float s = 0.f, q = 0.f;
#pragma unroll
                    for (int bj = 0; bj < 2; ++bj) { const f32x4 a = gelu4(acc[ai][bj][m][0]), b = gelu4(acc[ai][bj][m][1]);
                        s += ((a[0] + a[1]) + (a[2] + a[3])) + ((b[0] + b[1]) + (b[2] + b[3]));
                        q += ((a[0] * a[0] + a[1] * a[1]) + (a[2] * a[2] + a[3] * a[3])) + ((b[0] * b[0] + b[1] * b[1]) + (b[2] * b[2] + b[3] * b[3]));
                        *(u32x4*)(UV + (size_t)row * D_ + u.pn * BM + bj * HALF + cl) = pack8(a, b); }
                    if (isv) { s += __shfl_xor(s, 16); s += __shfl_xor(s, 32); q += __shfl_xor(q, 16); q += __shfl_xor(q, 32);
                        if (fq == 0) { atomicAdd(vsum + row, s); atomicAdd(vsq + row, q); } } }
        } else if (u.pn < 12) {
#pragma unroll
            for (int ai = 0; ai < 2; ++ai)
#pragma unroll
                for (int m = 0; m < 4; ++m) { const int row = row0 + ai * HALF + m * 16;
#pragma unroll
                    for (int bj = 0; bj < 2; ++bj) *(u32x4*)(P + (size_t)row * DS_ + (u.pn - 8) * BM + bj * HALF + cl) = pack8(acc[ai][bj][m][0], acc[ai][bj][m][1]); }
        } else {
            const int ch = (u.pn - 12) * HALF + cl;
#pragma unroll
            for (int ai = 0; ai < 2; ++ai)
#pragma unroll
                for (int m = 0; m < 4; ++m) { const int row = row0 + ai * HALF + m * 16; f32x4 r[2], g[2];
#pragma unroll
                    for (int n = 0; n < 2; ++n)
#pragma unroll
                        for (int e = 0; e < 4; ++e) { const float ea = exp_neg(acc[ai][0][m][n][e]), eb = exp_neg(acc[ai][1][m][n][e]);
                            const float ia = __builtin_amdgcn_rcpf(1.f + ea), ib = __builtin_amdgcn_rcpf(1.f + eb);
                            r[n][e] = (1.f + eb) * ia; g[n][e] = ib; }
                    *(u32x4*)(R + (size_t)row * D_ + ch) = pack8(r[0], r[1]); *(u32x4*)(GB + (size_t)row * D_ + ch) = pack8(g[0], g[1]); }
        }
    }
};
struct EpiMerge {
    static constexpr bool PERM = true, AFTER_DRAIN = false, KEEP = true;
    const bf16_t *R, *GB; bf16_t* MG;
    __device__ __forceinline__ void operator()(f32x4 (&acc)[2][2][4][2], const Unit& u, int wr, int wc, int fr, int fq) const {
        const int row0 = u.pm * BM + wr * 64 + fr, cl = u.pn * BM + wc * 32 + 8 * fq;
#pragma unroll
        for (int ai = 0; ai < 2; ++ai)
#pragma unroll
            for (int m = 0; m < 4; ++m) { const size_t off = (size_t)(row0 + ai * HALF + m * 16) * D_ + cl;
#pragma unroll
                for (int bj = 0; bj < 2; ++bj) {
                    if (u.z == 0) { f32x4 a, b; unpack8(*(const u32x4*)(R + off + bj * HALF), a, b); acc[ai][bj][m][0] *= a; acc[ai][bj][m][1] *= b; }
                    else { f32x4 a, b; unpack8(*(const u32x4*)(GB + off + bj * HALF), a, b); st16_wt(MG + off + bj * HALF, pack8(acc[ai][bj][m][0] * a, acc[ai][bj][m][1] * b)); } } }
    }
};
struct EpiSwiGLU {
    static constexpr bool PERM = true, AFTER_DRAIN = false, KEEP = false;
    bf16_t* H; const PG8_LAS float* rsT;
    __device__ __forceinline__ void operator()(f32x4 (&acc)[2][2][4][2], const Unit& u, int wr, int wc, int fr, int fq) const {
        const int row0 = u.pm * BM + wr * 64 + fr, cl = u.pn * HALF + wc * 32 + 8 * fq;
#pragma unroll
        for (int ai = 0; ai < 2; ++ai)
#pragma unroll
            for (int m = 0; m < 4; ++m) { f32x4 o[2]; const float rs = rsT[u.z * BM + wr * 64 + fr + ai * HALF + m * 16];
#pragma unroll
                for (int n = 0; n < 2; ++n)
#pragma unroll
                    for (int e = 0; e < 4; ++e) { const float g = acc[ai][0][m][n][e] * rs; o[n][e] = g * __builtin_amdgcn_rcpf(1.f + exp_neg(g)) * (acc[ai][1][m][n][e] * rs); }
                *(u32x4*)(H + (size_t)(row0 + ai * HALF + m * 16) * FF_ + cl) = pack8(o[0], o[1]); }
    }
};
__device__ __forceinline__ void row_sumsq_add(const f32x4 (&v)[2][2][4][2], float* st, int row0, int fq) {
#pragma unroll
    for (int ai = 0; ai < 2; ++ai)
#pragma unroll
        for (int m = 0; m < 4; ++m) { float s = 0.f;
#pragma unroll
            for (int bj = 0; bj < 2; ++bj)
#pragma unroll
                for (int n = 0; n < 2; ++n) { const f32x4 x = v[ai][bj][m][n]; s += (x[0] * x[0] + x[1] * x[1]) + (x[2] * x[2] + x[3] * x[3]); }
            s += __shfl_xor(s, 16); s += __shfl_xor(s, 32);
            if (fq == 0) atomicAdd(st + row0 + ai * HALF + m * 16, s); }
}
struct EpiNorm1 {
    static constexpr bool PERM = false, AFTER_DRAIN = true, KEEP = false;
    const float* x; bf16_t* xg; const float* g1; float *st1, *st2; unsigned *pword, *tmo;
    __device__ __forceinline__ void fused(f32x4 (&acc)[2][2][4][2], const Unit& u, int wr, int wc, int fr, int fq, PG8_LAS unsigned char* lds, int wid, int lane) const {
        const int row0 = u.pm * BM + wr * 64 + fr, col0 = u.pn * BM + wc * 32 + 4 * fq;
        row_sumsq_add(acc, st1, row0, fq);
        panel_barrier<false>(pword, tmo);
#pragma unroll
        for (int ai = 0; ai < 2; ++ai)
#pragma unroll
            for (int m = 0; m < 4; ++m) { const int row = row0 + ai * HALF + m * 16; const float rs = __builtin_amdgcn_rsqf(ld_agent(st1 + row) * (1.f / D_) + EPS_);
#pragma unroll
                for (int bj = 0; bj < 2; ++bj)
#pragma unroll
                    for (int n = 0; n < 2; ++n) { const size_t off = (size_t)row * D_ + col0 + bj * HALF + n * 16; const f32x4 g = *(const f32x4*)(g1 + col0 + bj * HALF + n * 16);
                        const f32x4 v = *(const f32x4*)(x + off) + acc[ai][bj][m][n] * rs * g; acc[ai][bj][m][n] = v;
                        u32x2 w; w.x = cvt_pk_bf16(v[0], v[1]); w.y = cvt_pk_bf16(v[2], v[3]);
                        *(PG8_LAS u32x2*)(lds + (wr * 64 + fr + ai * HALF + m * 16) * 528 + (wc * 32 + 4 * fq + bj * HALF + n * 16) * 2) = w; }
                asm volatile("" ::: "memory"); }
        row_sumsq_add(acc, st2, row0, fq);
        asm volatile("s_waitcnt lgkmcnt(0)" ::: "memory"); __builtin_amdgcn_s_barrier(); asm volatile("" ::: "memory");
        const int tid = wid * 64 + lane;
#pragma unroll
        for (int k = 0; k < 16; ++k) { const int q = tid + 512 * k, row = q >> 5, ch = q & 31;
            *(u32x4*)(xg + (size_t)(u.pm * BM + row) * D_ + u.pn * BM + 8 * ch) = *(const PG8_LAS u32x4*)(lds + row * 528 + ch * 16); }
    }
};
struct EpiNorm2 {
    static constexpr bool PERM = false, AFTER_DRAIN = true, KEEP = false;
    float* out; const bf16_t* x1b; const float* g3; float* st3; unsigned *pword, *tmo;
    __device__ __forceinline__ void fused(f32x4 (&acc)[2][2][4][2], const Unit& u, int wr, int wc, int fr, int fq, PG8_LAS unsigned char*, int, int) const {
        const int row0 = u.pm * BM + wr * 64 + fr, col0 = u.pn * BM + wc * 32 + 4 * fq;
        row_sumsq_add(acc, st3, row0, fq);
        panel_barrier<false>(pword, tmo);
#pragma unroll
        for (int ai = 0; ai < 2; ++ai)
#pragma unroll
            for (int m = 0; m < 4; ++m) { const int row = row0 + ai * HALF + m * 16; const float rs = __builtin_amdgcn_rsqf(ld_agent(st3 + row) * (1.f / D_) + EPS_);
#pragma unroll
                for (int bj = 0; bj < 2; ++bj)
#pragma unroll
                    for (int n = 0; n < 2; ++n) { const size_t off = (size_t)row * D_ + col0 + bj * HALF + n * 16; const f32x4 g = *(const f32x4*)(g3 + col0 + bj * HALF + n * 16);
                        const u32x2 xb = *(const u32x2*)(x1b + off); const f32x4 x1v = (f32x4){bf_lo(xb.x), bf_hi(xb.x), bf_lo(xb.y), bf_hi(xb.y)};
                        *(f32x4*)(out + off) = x1v + acc[ai][bj][m][n] * rs * g; }
                asm volatile("" ::: "memory"); }
    }
};
struct EpiNull {
    static constexpr bool PERM = false, AFTER_DRAIN = false, KEEP = false;
    float* sink;
    __device__ __forceinline__ void operator()(f32x4 (&acc)[2][2][4][2], const Unit& u, int wr, int wc, int fr, int fq) const {
        float s = 0.f;
#pragma unroll
        for (int ai = 0; ai < 2; ++ai)
#pragma unroll
            for (int m = 0; m < 4; ++m)
#pragma unroll
                for (int bj = 0; bj < 2; ++bj)
#pragma unroll
                    for (int n = 0; n < 2; ++n) s += acc[ai][bj][m][n][0] + acc[ai][bj][m][n][1] + acc[ai][bj][m][n][2] + acc[ai][bj][m][n][3];
        if (s == 1234.5678f) sink[0] = s;
    }
};
struct IdxOrder {
    StaticOrder so;
    __device__ bool next(int i, Unit& u) const { if (!so.next(i, u)) return false; u.z = i; return true; }
    __device__ __forceinline__ void a_ready(const Unit&) const {}
    __device__ __forceinline__ void done(const Unit&) const {}
};
struct RangeOrder {
    StaticOrder so; int base, count;
    __device__ bool next(int i, Unit& u) const { return i < count && so.next(base + i, u); }
    __device__ __forceinline__ void a_ready(const Unit&) const {}
    __device__ __forceinline__ void done(const Unit&) const {}
};
struct PairOrder {
    StaticOrder so;
    __device__ bool next(int i, Unit& u) const { if (!so.next(i >> 1, u)) return false; u.z = i & 1; return true; }
    __device__ __forceinline__ void a_ready(const Unit&) const {}
    __device__ __forceinline__ void done(const Unit&) const {}
};
template <class Epi, class Sched, bool ALIGN_EPI = false, bool SP2 = false>
__device__ __forceinline__ void gemm_phase(PG8_LAS unsigned char* lds, const Gemm g, const Sched& S, const Epi& E) {
    const int tid = threadIdx.x, wid = __builtin_amdgcn_readfirstlane(tid >> 6), lane = tid & 63, wr = wid >> 2, wc = wid & 3, fr = lane & 15, fq = lane >> 4;
    const int K = g.K, nt = K / BK;
    unsigned voffA[2], voffB[2];
#pragma unroll
    for (int i = 0; i < 2; ++i) { int R, C; stage_rc(tid * 16 + i * 8192, R, C); const int Rb = Epi::PERM ? ((R & ~31) + perm32(R & 31)) : R;
        voffA[i] = (unsigned)(R * K + C) * 2u; voffB[i] = (unsigned)(Rb * K + C) * 2u; }
    const size_t kstep = (size_t)(BK * 2);
    const size_t hstep = (size_t)HALF * K * 2;
    const size_t tstep = 2 * hstep;
    const unsigned ldsw = (unsigned)wid * 1024u;
    const int aoff = lds_byte(wr * 64 + fr, fq * 8), boff = lds_byte(wc * 32 + fr, fq * 8);
#define PG8_SA(b, h) (((b) * 2 + (h)) * HTB)
#define PG8_SB(b, h) ((4 + (b) * 2 + (h)) * HTB)
#define PG8_STAGE(bufoff, gbase, voff) do { _Pragma("unroll") for (int _i = 0; _i < 2; ++_i) \
        __builtin_amdgcn_global_load_lds((const unsigned*)((const char*)(gbase) + (voff)[_i]), (PG8_LAS unsigned*)(lds + (bufoff) + ldsw + _i * 8192), 16, 0, 0); } while (0)
#define PG8_LDA(dst, b, h) do { _Pragma("unroll") for (int m = 0; m < 4; ++m) _Pragma("unroll") for (int k = 0; k < 2; ++k) dst[m][k] = *(const PG8_LAS bf16x8*)(lds + PG8_SA(b, h) + aoff + m * 2048 + k * 1024); } while (0)
#define PG8_LDB(dst, b, h) do { _Pragma("unroll") for (int n = 0; n < 2; ++n) _Pragma("unroll") for (int k = 0; k < 2; ++k) dst[n][k] = *(const PG8_LAS bf16x8*)(lds + PG8_SB(b, h) + boff + n * 2048 + k * 1024); } while (0)
#define PG8_MMA(ai, bj, At, Bt) do { __builtin_amdgcn_s_setprio(1); _Pragma("unroll") for (int m = 0; m < 4; ++m) _Pragma("unroll") for (int n = 0; n < 2; ++n) _Pragma("unroll") for (int k = 0; k < 2; ++k) \
        acc[ai][bj][m][n] = __builtin_amdgcn_mfma_f32_16x16x32_bf16(Bt[n][k], At[m][k], acc[ai][bj][m][n], 0, 0, 0); __builtin_amdgcn_s_setprio(0); } while (0)
#define PG8_WAIT_V(n) asm volatile("s_waitcnt vmcnt(" #n ")" ::: "memory")
#define PG8_WAIT_L(n) asm volatile("s_waitcnt lgkmcnt(" #n ")" ::: "memory")
#define PG8_BAR __builtin_amdgcn_s_barrier()
#define PG8_SCHED __builtin_amdgcn_sched_barrier(0)
    Unit cur, nxt; int ui = 0;
    if (!S.next(0, cur)) return;
    f32x4 acc[2][2][4][2];
#pragma unroll
    for (int a = 0; a < 2; ++a)
#pragma unroll
        for (int b = 0; b < 2; ++b)
#pragma unroll
            for (int m = 0; m < 4; ++m)
#pragma unroll
                for (int n = 0; n < 2; ++n) acc[a][b][m][n] = (f32x4){0.f, 0.f, 0.f, 0.f};
    bf16x8 At[4][2], B0[2][2], B1[2][2];
    const char* cA = (const char*)(cur.z ? g.A1 : g.A0) + (size_t)cur.pm * tstep; const char* cB = (const char*)(cur.z ? g.B1 : g.B0) + (size_t)cur.pn * tstep;
    S.a_ready(cur);
    if constexpr (SP2) {
        PG8_STAGE(PG8_SB(0, 0), cB, voffB); PG8_STAGE(PG8_SB(0, 1), cB + hstep, voffB); PG8_STAGE(PG8_SA(0, 0), cA, voffA); PG8_STAGE(PG8_SA(0, 1), cA + hstep, voffA);
        if (wr == 1) PG8_BAR;
        PG8_WAIT_V(2); PG8_BAR;
        PG8_STAGE(PG8_SB(1, 0), cB + kstep, voffB); PG8_STAGE(PG8_SA(1, 0), cA + kstep, voffA); PG8_STAGE(PG8_SB(1, 1), cB + hstep + kstep, voffB);
        PG8_WAIT_V(6); PG8_BAR;
    } else {
        PG8_STAGE(PG8_SB(0, 0), cB, voffB); PG8_STAGE(PG8_SA(0, 0), cA, voffA); PG8_STAGE(PG8_SB(0, 1), cB + hstep, voffB); PG8_STAGE(PG8_SA(0, 1), cA + hstep, voffA);
        if (wr == 1) PG8_BAR;
        PG8_WAIT_V(4); PG8_BAR;
        PG8_STAGE(PG8_SB(1, 0), cB + kstep, voffB); PG8_STAGE(PG8_SA(1, 0), cA + kstep, voffA); PG8_STAGE(PG8_SB(1, 1), cB + hstep + kstep, voffB);
        PG8_WAIT_V(6); PG8_BAR;
    }
    for (;;) {
        const bool has_next = S.next(ui + 1, nxt);
        const char* nA = has_next ? (const char*)(nxt.z ? g.A1 : g.A0) + (size_t)nxt.pm * tstep : cA; const char* nB = has_next ? (const char*)(nxt.z ? g.B1 : g.B0) + (size_t)nxt.pn * tstep : cB;
        for (int t = 0; t < nt; t += 2) {
            const bool last = (t == nt - 2);
            const char* a1 = cA + (size_t)(t + 1) * kstep;
            const char* a2 = last ? nA : cA + (size_t)(t + 2) * kstep; const char* b2 = last ? nB : cB + (size_t)(t + 2) * kstep;
            const char* a3 = a2 + kstep; const char* b3 = b2 + kstep;
            if (last && has_next) S.a_ready(nxt);
            if constexpr (SP2) {
            PG8_LDB(B0, 0, 0); PG8_LDB(B1, 0, 1); PG8_SCHED; PG8_LDA(At, 0, 0); PG8_STAGE(PG8_SA(1, 1), a1 + hstep, voffA);
            PG8_WAIT_V(8); PG8_WAIT_L(0); PG8_BAR; PG8_MMA(0, 0, At, B0); PG8_MMA(0, 1, At, B1); PG8_BAR; PG8_SCHED;
            PG8_LDA(At, 0, 1); PG8_STAGE(PG8_SB(0, 0), b2, voffB); PG8_STAGE(PG8_SB(0, 1), b2 + hstep, voffB); PG8_STAGE(PG8_SA(0, 0), a2, voffA);
            PG8_WAIT_V(8); PG8_WAIT_L(0); PG8_BAR; PG8_MMA(1, 0, At, B0); PG8_MMA(1, 1, At, B1); PG8_BAR; PG8_SCHED;
            PG8_LDB(B0, 1, 0); PG8_LDB(B1, 1, 1); PG8_SCHED; PG8_LDA(At, 1, 0); PG8_STAGE(PG8_SA(0, 1), a2 + hstep, voffA);
            PG8_WAIT_V(8); PG8_WAIT_L(0); PG8_BAR; PG8_MMA(0, 0, At, B0); PG8_MMA(0, 1, At, B1); PG8_BAR; PG8_SCHED;
            PG8_LDA(At, 1, 1); PG8_STAGE(PG8_SB(1, 0), b3, voffB); PG8_STAGE(PG8_SB(1, 1), b3 + hstep, voffB); PG8_STAGE(PG8_SA(1, 0), a3, voffA);
            PG8_WAIT_V(8); PG8_WAIT_L(0); PG8_BAR; PG8_MMA(1, 0, At, B0); PG8_MMA(1, 1, At, B1); PG8_BAR; PG8_SCHED;
            } else {
            PG8_LDB(B0, 0, 0); PG8_SCHED; PG8_LDA(At, 0, 0); PG8_STAGE(PG8_SA(1, 1), a1 + hstep, voffA);
            PG8_WAIT_L(8); PG8_BAR; PG8_WAIT_L(0); PG8_MMA(0, 0, At, B0); PG8_BAR; PG8_SCHED;
            PG8_LDB(B1, 0, 1); PG8_STAGE(PG8_SB(0, 0), b2, voffB);
            PG8_BAR; PG8_WAIT_L(0); PG8_MMA(0, 1, At, B1); PG8_BAR;
            PG8_LDA(At, 0, 1); PG8_STAGE(PG8_SA(0, 0), a2, voffA);
            PG8_BAR; PG8_WAIT_L(0); PG8_MMA(1, 0, At, B0); PG8_BAR; PG8_SCHED;
            PG8_STAGE(PG8_SB(0, 1), b2 + hstep, voffB);
            PG8_WAIT_V(6); PG8_BAR; PG8_MMA(1, 1, At, B1); PG8_BAR;
            PG8_LDB(B0, 1, 0); PG8_SCHED; PG8_LDA(At, 1, 0); PG8_STAGE(PG8_SA(0, 1), a2 + hstep, voffA);
            PG8_WAIT_L(8); PG8_BAR; PG8_WAIT_L(0); PG8_MMA(0, 0, At, B0); PG8_BAR; PG8_SCHED;
            PG8_LDB(B1, 1, 1); PG8_STAGE(PG8_SB(1, 0), b3, voffB);
            PG8_BAR; PG8_WAIT_L(0); PG8_MMA(0, 1, At, B1); PG8_BAR;
            PG8_LDA(At, 1, 1); PG8_STAGE(PG8_SA(1, 0), a3, voffA);
            PG8_BAR; PG8_WAIT_L(0); PG8_MMA(1, 0, At, B0); PG8_BAR; PG8_SCHED;
            PG8_STAGE(PG8_SB(1, 1), b3 + hstep, voffB);
            PG8_WAIT_V(6); PG8_BAR; PG8_MMA(1, 1, At, B1); PG8_BAR;
            }
        }
        if constexpr (ALIGN_EPI) { if (wr == 0) PG8_BAR; }
        if constexpr (!Epi::AFTER_DRAIN) { E(acc, cur, wr, wc, fr, fq); S.done(cur); }
        if (!has_next) break;
        if (!(Epi::KEEP && cur.z == 0))
#pragma unroll
        for (int a = 0; a < 2; ++a)
#pragma unroll
            for (int b = 0; b < 2; ++b)
#pragma unroll
                for (int m = 0; m < 4; ++m)
#pragma unroll
                    for (int n = 0; n < 2; ++n) acc[a][b][m][n] = (f32x4){0.f, 0.f, 0.f, 0.f};
        cur = nxt; cA = nA; cB = nB; ++ui;
        if constexpr (ALIGN_EPI) { if (wr == 1) PG8_BAR; }
    }
    PG8_WAIT_V(0);
    if constexpr (!ALIGN_EPI) { if (wr == 0) PG8_BAR; }
    PG8_BAR;
    if constexpr (Epi::AFTER_DRAIN) { E.fused(acc, cur, wr, wc, fr, fq, lds, wid, lane); S.done(cur); }
#undef PG8_SA
#undef PG8_SB
#undef PG8_STAGE
#undef PG8_LDA
#undef PG8_LDB
#undef PG8_MMA
#undef PG8_WAIT_V
#undef PG8_WAIT_L
#undef PG8_BAR
#undef PG8_SCHED
}
}

constexpr int NWAVES = 8, NTHREADS = 512;
constexpr int SEQ = 4096, M = 8192, D = 2048, DS = 1024, DP = 1024, DIN = 7168, FF = 5632;
constexpr float EPS = 1e-6f;
constexpr size_t MiB = 1u << 20;
constexpr size_t WS_STAT = 0;
constexpr size_t WS_BAR = 1 * MiB;
constexpr int PW_BASE = 4096, PW_SEAM = 32 * 64;
constexpr size_t WS_WIN = 2 * MiB;
constexpr size_t WS_XG = 2 * MiB;
constexpr size_t WS_WAB = 34 * MiB;
constexpr size_t WS_WOUT = 42 * MiB;
constexpr size_t WS_WGU = 50 * MiB;
constexpr size_t WS_WDN = 94 * MiB;
constexpr size_t WS_PWT = 116 * MiB;
constexpr size_t WS_SGW = 116 * MiB + 512 * 1024;
constexpr size_t WS_XN = 117 * MiB;
constexpr size_t WS_UV = 149 * MiB;
constexpr size_t WS_P = 181 * MiB;
constexpr size_t WS_R = 197 * MiB;
constexpr size_t WS_GB = 229 * MiB;
constexpr size_t WS_HID = 149 * MiB;
constexpr size_t WS_END = 261 * MiB;
static_assert(WS_HID + (size_t)M * FF * 2 <= WS_END && WS_WDN + (size_t)D * FF * 2 <= WS_PWT && WS_WGU + (size_t)2 * FF * D * 2 <= WS_WDN, "d_ws map");
constexpr int MISC_OFF = 147392;
constexpr int LDS_BYTES = 147456;

typedef unsigned short bf16;
typedef pg8::f32x4 f32x4;
typedef pg8::u32x4 u32x4;
typedef pg8::u32x2 u32x2;
typedef pg8::bf16x8 bf16x8;
using pg8::cvt_pk_bf16; using pg8::bf_lo; using pg8::bf_hi; using pg8::pack8; using pg8::unpack8; using pg8::ld_agent;

struct Args { const float* in[18]; float* out; unsigned char* ws; };
struct Frame {
    LAS unsigned char* lds; int tid, lane, wave, G, bid;
    const float *x, *norm1_pre, *w_in, *v_ln_g, *v_ln_b, *sgu_w, *sgu_b, *pool_w, *pool_scale, *w_a, *w_b, *w_out, *norm1_post, *norm2_pre, *w_gate, *w_up, *w_down, *norm2_post;
    float* out; float *vsum, *vsq, *st1, *st2, *st3;
    bf16 *WIN, *WAB, *WOUT, *WGU, *WDN, *PWT, *SGW, *XN, *XG, *YA, *YB, *UV, *MG, *P, *R, *GB, *HID;
};
__device__ __forceinline__ float wave_sum(float v) {
#pragma unroll
    for (int o = 1; o < 64; o <<= 1) v += __shfl_xor(v, o);
    return v;
}
struct TItem { const float* src; bf16* dst; const float* ks; int N, ldo, mode, pad; };
__device__ __forceinline__ TItem mk_item(const float* W, int N, int k0, int n0, bf16* WT, int ldo, int orow0, const float* kscale = nullptr, int mode = 0) {
    TItem t; t.mode = mode; t.pad = 0; t.src = W + (size_t)k0 * N + n0; t.dst = WT + (size_t)orow0 * ldo + k0; t.ks = kscale ? kscale + k0 : nullptr; t.N = N; t.ldo = ldo; return t; }
__device__ __forceinline__ void titem_load(const TItem& t, f32x4 (&v)[16], int lane) {
    const int lr = lane >> 4, lc = 4 * (lane & 15);
#pragma unroll
    for (int i = 0; i < 16; ++i) v[i] = __builtin_nontemporal_load((const f32x4*)(t.src + (size_t)(4 * i + lr) * t.N + lc));
}
template <bool NT>
__device__ __forceinline__ void titem_finish(const TItem& t, const f32x4 (&v)[16], LAS float* scr, int lane) {
    const int lr = lane >> 4, lc = 4 * (lane & 15);
#pragma unroll
    for (int i = 0; i < 16; ++i) { const int kk = 4 * i + lr; scr[kk * 65 + lc + 0] = v[i][0]; scr[kk * 65 + lc + 1] = v[i][1]; scr[kk * 65 + lc + 2] = v[i][2]; scr[kk * 65 + lc + 3] = v[i][3]; }
    asm volatile("s_waitcnt lgkmcnt(0)" ::: "memory");
    const int c = lane & 7;
    f32x4 ks0 = (f32x4){1.f, 1.f, 1.f, 1.f}, ks1 = ks0;
    if (t.ks) { ks0 = *(const f32x4*)(t.ks + 8 * c); ks1 = *(const f32x4*)(t.ks + 8 * c + 4); }
#pragma unroll
    for (int jj = 0; jj < 8; ++jj) { const int n = 8 * jj + (lane >> 3); const LAS float* s = scr + (8 * c) * 65 + n;
        u32x4 o; o.x = cvt_pk_bf16(s[0 * 65] * ks0[0], s[1 * 65] * ks0[1]); o.y = cvt_pk_bf16(s[2 * 65] * ks0[2], s[3 * 65] * ks0[3]); o.z = cvt_pk_bf16(s[4 * 65] * ks1[0], s[5 * 65] * ks1[1]); o.w = cvt_pk_bf16(s[6 * 65] * ks1[2], s[7 * 65] * ks1[3]);
        if (t.mode == 2) st16_wt(t.dst + (size_t)n * t.ldo + 8 * c, o); else if (NT) __builtin_nontemporal_store(o, (u32x4*)(t.dst + (size_t)n * t.ldo + 8 * c)); else *(u32x4*)(t.dst + (size_t)n * t.ldo + 8 * c) = o; }
    asm volatile("s_waitcnt lgkmcnt(0)" ::: "memory");
}
constexpr int I_IN = (D / 64) * (DIN / 64), I_A = (DS / 64) * (D / 64), I_OUT = (D / 64) * (D / 64), I_G = (D / 64) * (FF / 64), I_D = (FF / 64) * (D / 64), I_PW = 4 * 16;
__device__ __forceinline__ int win_orow(int n0) { if (n0 < 3072) return n0; const int q = n0 - 3072, isb = q / D, c = q % D; return 3072 + (c / 128) * 256 + isb * 128 + (c % 128); }
constexpr int I_INH = 32 * 56;
template <int SET>
__device__ __forceinline__ TItem decode_item(const Frame& F, int r) {
    if constexpr (SET == 0) {
        if (r < I_INH) { const int e = r % 56, k0 = 64 * (r / 56), n0 = 64 * (e < 28 ? e : (e < 42 ? 24 + e : 42 + e)); return mk_item(F.w_in, DIN, k0, n0, F.WIN, D, win_orow(n0)); } r -= I_INH;
        const int g = r / 16, rr = r % 16; return mk_item(F.pool_w + (size_t)g * 65536, 256, 64 * (rr / 4), 64 * (rr % 4), F.PWT + (size_t)g * 65536, 256, 64 * (rr % 4));
    } else if constexpr (SET == 3) {
        const int l = r % 56, k0 = 64 * (r / 56), n0 = 64 * (l < 24 ? 28 + l : (l < 42 ? 42 + l : 56 + l));
        return mk_item(F.w_in, DIN, k0, n0, F.WIN, D, win_orow(n0), nullptr, 2);
    } else if constexpr (SET == 1) {
        if (r < I_A) { const int nblk = D / 64; return mk_item(F.w_a, D, 64 * (r / nblk), 64 * (r % nblk), F.WAB, DS, 64 * (r % nblk)); } r -= I_A;
        if (r < I_A) { const int nblk = D / 64; return mk_item(F.w_b, D, 64 * (r / nblk), 64 * (r % nblk), F.WAB + (size_t)D * DS, DS, 64 * (r % nblk)); } r -= I_A;
        if (r < I_OUT) { const int nblk = D / 64; return mk_item(F.w_out, D, 64 * (r / nblk), 64 * (r % nblk), F.WOUT, D, 64 * (r % nblk)); } r -= I_OUT;
        if (r < I_G) { const int nblk = FF / 64, n0 = 64 * (r % nblk); return mk_item(F.w_gate, FF, 64 * (r / nblk), n0, F.WGU, D, (n0 / 128) * 256 + (n0 % 128), F.norm2_pre); } r -= I_G;
        const int nblk = FF / 64, n0 = 64 * (r % nblk); return mk_item(F.w_up, FF, 64 * (r / nblk), n0, F.WGU, D, (n0 / 128) * 256 + 128 + (n0 % 128), F.norm2_pre);
    } else {
        const int nblk = D / 64; return mk_item(F.w_down, D, 64 * (r / nblk), 64 * (r % nblk), F.WDN, FF, 64 * (r % nblk));
    }
}
template <int SET>
__device__ __forceinline__ void convert_weights(const Frame& F, int gw, int NGW) {
    LAS float* scr = (LAS float*)(F.lds + F.wave * 16640);
    constexpr int NITEMS = SET == 0 ? I_INH + I_PW : (SET == 1 ? 2 * I_A + I_OUT + 2 * I_G : (SET == 3 ? I_INH : I_D));
    int it = gw; if (it >= NITEMS) return;
    TItem cur = decode_item<SET>(F, it); f32x4 v[16]; titem_load(cur, v, F.lane);
    for (;;) {
        const int nit = it + NGW; const bool hn = nit < NITEMS;
        TItem nx = cur; f32x4 nv[16];
        if (hn) { nx = decode_item<SET>(F, nit); titem_load(nx, nv, F.lane); }
        titem_finish<SET == 1>(cur, v, scr, F.lane);
        if (!hn) break;
        cur = nx; it = nit;
#pragma unroll
        for (int i = 0; i < 16; ++i) v[i] = nv[i];
    }
}
__device__ __forceinline__ void p0_prologue(const Frame& F) {
    const int gw = F.bid * NWAVES + F.wave, NGW = F.G * NWAVES;
    for (int i = F.bid * NTHREADS + F.tid; i < 5 * M; i += F.G * NTHREADS) F.vsum[i] = 0.f;
    for (int i = (F.bid * NTHREADS + F.tid) * 8; i < 8 * 128 * 128; i += F.G * NTHREADS * 8) {
        const f32x4 a = *(const f32x4*)(F.sgu_w + i), b = *(const f32x4*)(F.sgu_w + i + 4); *(u32x4*)(F.SGW + i) = pack8(a, b); }
    {
        const f32x4* gr = (const f32x4*)F.norm1_pre + F.lane;
        int m = gw; f32x4 v[8];
        if (m < M) { const f32x4* xr = (const f32x4*)(F.x + (size_t)m * D) + F.lane;
#pragma unroll
            for (int j = 0; j < 8; ++j) v[j] = xr[64 * j]; }
        while (m < M) {
            const int nm = m + NGW; f32x4 nv[8];
            if (nm < M) { const f32x4* xr = (const f32x4*)(F.x + (size_t)nm * D) + F.lane;
#pragma unroll
                for (int j = 0; j < 8; ++j) nv[j] = xr[64 * j]; }
            float s = 0.f;
#pragma unroll
            for (int j = 0; j < 8; ++j) s += (v[j][0] * v[j][0] + v[j][1] * v[j][1]) + (v[j][2] * v[j][2] + v[j][3] * v[j][3]);
            const float rs = __builtin_amdgcn_rsqf(wave_sum(s) * (1.f / D) + EPS);
            u32x2* o = (u32x2*)(F.XN + (size_t)m * D) + F.lane;
#pragma unroll
            for (int j = 0; j < 8; ++j) { const f32x4 t = v[j] * rs * gr[64 * j]; u32x2 w; w.x = cvt_pk_bf16(t[0], t[1]); w.y = cvt_pk_bf16(t[2], t[3]); o[64 * j] = w; }
            if (nm < M) {
#pragma unroll
                for (int j = 0; j < 8; ++j) v[j] = nv[j]; }
            m = nm;
        }
    }
    convert_weights<0>(F, gw, NGW);
}
constexpr int VS = 136, PS = 264;
__device__ __forceinline__ void sgu_unit(const Frame& F, int nb, int h) {
    LAS bf16* Vt = (LAS bf16*)F.lds;
    const int lane = F.lane, w = F.wave, fr = lane & 15, fq = lane >> 4, t0 = nb * 128;
    const int nks = (w < 4) ? 2 : 4;
    bf16x8 Af[4];
#pragma unroll
    for (int ks = 0; ks < 4; ++ks) Af[ks] = *(const bf16x8*)(F.SGW + ((size_t)(h * 128 + 16 * w + fr) * 128 + (ks < nks ? ks : 0) * 32 + 8 * fq));
    LAS unsigned char* Us = F.lds + 34816;
    u32x4 ureg[4];
#pragma unroll
    for (int k = 0; k < 4; ++k) ureg[k] = *(const u32x4*)(F.UV + (size_t)(t0 + (F.tid >> 4) + 32 * k) * D + h * 128 + 8 * (F.tid & 15));
#pragma unroll
    for (int it = 0; it < 2; ++it) {
        const int idx = F.tid + NTHREADS * it, chunk = idx & 15, j = 2 * (idx >> 4);
        const bf16* src = F.UV + (size_t)(t0 + j) * D + DS + h * 128 + 8 * chunk;
        f32x4 a0, a1, b0, b1; unpack8(*(const u32x4*)src, a0, a1); unpack8(*(const u32x4*)(src + D), b0, b1);
        const float mu0 = ld_agent(F.vsum + t0 + j) * (1.f / DS), mu1 = ld_agent(F.vsum + t0 + j + 1) * (1.f / DS);
        const float rs0 = __builtin_amdgcn_rsqf(fmaxf(ld_agent(F.vsq + t0 + j) * (1.f / DS) - mu0 * mu0, 0.f) + EPS), rs1 = __builtin_amdgcn_rsqf(fmaxf(ld_agent(F.vsq + t0 + j + 1) * (1.f / DS) - mu1 * mu1, 0.f) + EPS);
        const f32x4 g0 = *(const f32x4*)(F.v_ln_g + h * 128 + 8 * chunk), g1 = *(const f32x4*)(F.v_ln_g + h * 128 + 8 * chunk + 4);
        const f32x4 c0 = *(const f32x4*)(F.v_ln_b + h * 128 + 8 * chunk), c1 = *(const f32x4*)(F.v_ln_b + h * 128 + 8 * chunk + 4);
        const f32x4 y00 = (a0 - mu0) * rs0 * g0 + c0, y01 = (a1 - mu0) * rs0 * g1 + c1, y10 = (b0 - mu1) * rs1 * g0 + c0, y11 = (b1 - mu1) * rs1 * g1 + c1;
#pragma unroll
        for (int q = 0; q < 4; ++q) { *(LAS unsigned*)(Vt + (8 * chunk + q) * VS + j) = cvt_pk_bf16(y00[q], y10[q]); *(LAS unsigned*)(Vt + (8 * chunk + 4 + q) * VS + j) = cvt_pk_bf16(y01[q], y11[q]); }
    }
#pragma unroll
    for (int k = 0; k < 4; ++k) *(LAS u32x4*)(Us + ((F.tid >> 4) + 32 * k) * 272 + (F.tid & 15) * 16) = ureg[k];
    __syncthreads();
    f32x4 acc[8];
#pragma unroll
    for (int nt = 0; nt < 8; ++nt) acc[nt] = (f32x4){0.f, 0.f, 0.f, 0.f};
#pragma unroll
    for (int ks = 0; ks < 4; ++ks) if (ks < nks) {
#pragma unroll
        for (int nt = 0; nt < 8; ++nt) { const bf16x8 Bf = *(const LAS bf16x8*)(Vt + (16 * nt + fr) * VS + 32 * ks + 8 * fq); acc[nt] = __builtin_amdgcn_mfma_f32_16x16x32_bf16(Bf, Af[ks], acc[nt], 0, 0, 0); } }
    const int i = 16 * w + fr; const float bias = F.sgu_b[h * 128 + i];
    LAS unsigned char* ost = F.lds + 69632 + w * 4352;
#pragma unroll
    for (int nt = 0; nt < 8; ++nt) { const u32x2 uu = *(const LAS u32x2*)(Us + i * 272 + (16 * nt + 4 * fq) * 2);
        u32x2 o; o.x = cvt_pk_bf16(bf_lo(uu.x) * (acc[nt][0] + bias), bf_hi(uu.x) * (acc[nt][1] + bias)); o.y = cvt_pk_bf16(bf_lo(uu.y) * (acc[nt][2] + bias), bf_hi(uu.y) * (acc[nt][3] + bias));
        *(LAS u32x2*)(ost + fr * 272 + (16 * nt + 4 * fq) * 2) = o; }
    asm volatile("s_waitcnt lgkmcnt(0)" ::: "memory");
#pragma unroll
    for (int k = 0; k < 4; ++k) { const int q = lane + 64 * k, row = q >> 4, ch = q & 15;
        st16_wt(F.YA + (size_t)(t0 + 16 * w + row) * DS + h * 128 + 8 * ch, *(const LAS u32x4*)(ost + row * 272 + ch * 16)); }
    __syncthreads();
}
template <int WIN>
__device__ __forceinline__ void pool_stage(const Frame& F, LAS bf16* Ap, int t0, int g) {
    const int chunk = F.tid & 31, tb = 8 * (F.tid >> 5), pos0 = (t0 & (SEQ - 1)) + tb;
    const bf16* src = F.P + (size_t)(t0 + tb) * DP + g * 256 + 8 * chunk;
    constexpr int NR = 8 + WIN - 1;
    u32x4 raw[NR];
#pragma unroll
    for (int r = 0; r < NR; ++r) { const int d = r - (WIN - 1);
        raw[r] = (pos0 + d >= 0) ? *(const u32x4*)(src + (ptrdiff_t)d * DP) : (u32x4){0u, 0u, 0u, 0u}; }
    f32x4 s0 = (f32x4){0.f, 0.f, 0.f, 0.f}, s1 = s0;
#pragma unroll
    for (int r = 0; r < WIN - 1; ++r) { f32x4 a, b; unpack8(raw[r], a, b); s0 += a; s1 += b; }
#pragma unroll
    for (int i = 0; i < 8; ++i) { f32x4 a, b; unpack8(raw[WIN - 1 + i], a, b); s0 += a; s1 += b;
        const int pos = pos0 + i; const float inv = 1.f / (float)((pos + 1 < WIN) ? pos + 1 : WIN);
        *(LAS u32x4*)(Ap + (tb + i) * PS + 8 * chunk) = pack8(s0 * inv - a, s1 * inv - b);
        f32x4 c, d; unpack8(raw[i], c, d); s0 -= c; s1 -= d; }
}
__device__ __forceinline__ void pool_unit(const Frame& F, int nb, int g) {
    LAS bf16* Ap = (LAS bf16*)F.lds;
    LAS unsigned char* Bs = F.lds + 67584;
    const int lane = F.lane, w = F.wave, fr = lane & 15, fq = lane >> 4, t0 = nb * 128;
    const bf16* Bsrc = F.PWT + (size_t)g * 65536 + (size_t)(F.tid >> 4) * 256 + 8 * (F.tid & 15);
    u32x4 breg[8];
#pragma unroll
    for (int i = 0; i < 8; ++i) breg[i] = *(const u32x4*)(Bsrc + (size_t)(32 * i) * 256);
    switch (g) { case 0: pool_stage<2>(F, Ap, t0, g); break; case 1: pool_stage<4>(F, Ap, t0, g); break; case 2: pool_stage<8>(F, Ap, t0, g); break; default: pool_stage<16>(F, Ap, t0, g); break; }
#pragma unroll
    for (int i = 0; i < 8; ++i) *(LAS u32x4*)(Bs + ((F.tid >> 4) + 32 * i) * 272 + (F.tid & 15) * 16) = breg[i];
    __syncthreads();
#pragma unroll
    for (int i = 0; i < 8; ++i) breg[i] = *(const u32x4*)(Bsrc + (size_t)(32 * i) * 256 + 128);
    const int wm = w >> 2, wn = w & 3;
    f32x4 acc[4][4];
#pragma unroll
    for (int a = 0; a < 4; ++a)
#pragma unroll
        for (int b = 0; b < 4; ++b) acc[a][b] = (f32x4){0.f, 0.f, 0.f, 0.f};
#pragma unroll
    for (int h = 0; h < 2; ++h) {
#pragma unroll
        for (int ks = 0; ks < 4; ++ks) {
            bf16x8 Af[4], Bf[4];
#pragma unroll
            for (int ni = 0; ni < 4; ++ni) Bf[ni] = *(const LAS bf16x8*)(Bs + (64 * wn + 16 * ni + fr) * 272 + (32 * ks + 8 * fq) * 2);
#pragma unroll
            for (int mi = 0; mi < 4; ++mi) Af[mi] = *(const LAS bf16x8*)(Ap + (64 * wm + 16 * mi + fr) * PS + 128 * h + 32 * ks + 8 * fq);
#pragma unroll
            for (int mi = 0; mi < 4; ++mi)
#pragma unroll
                for (int ni = 0; ni < 4; ++ni) acc[mi][ni] = __builtin_amdgcn_mfma_f32_16x16x32_bf16(Bf[ni], Af[mi], acc[mi][ni], 0, 0, 0);
        }
        __syncthreads();
        if (h == 0) {
#pragma unroll
            for (int i = 0; i < 8; ++i) *(LAS u32x4*)(Bs + ((F.tid >> 4) + 32 * i) * 272 + (F.tid & 15) * 16) = breg[i];
            __syncthreads(); }
    }
    LAS unsigned char* ost = F.lds + 67584 + w * 8704;
#pragma unroll
    for (int ni = 0; ni < 4; ++ni) { const int d = g * 256 + 64 * wn + 16 * ni + 4 * fq; const f32x4 sc = *(const f32x4*)(F.pool_scale + d);
#pragma unroll
        for (int mi = 0; mi < 4; ++mi) { const f32x4 o = acc[mi][ni] * sc; u32x2 wv; wv.x = cvt_pk_bf16(o[0], o[1]); wv.y = cvt_pk_bf16(o[2], o[3]);
            *(LAS u32x2*)(ost + (16 * mi + fr) * 136 + (16 * ni + 4 * fq) * 2) = wv; } }
    asm volatile("s_waitcnt lgkmcnt(0)" ::: "memory");
#pragma unroll
    for (int k = 0; k < 8; ++k) { const int q = lane + 64 * k, row = q >> 3, ch = q & 7;
        const LAS unsigned* p = (const LAS unsigned*)(ost + row * 136 + ch * 16);
        st16_wt(F.YB + (size_t)(t0 + 64 * wm + row) * DP + g * 256 + 64 * wn + 8 * ch, (u32x4){p[0], p[1], p[2], p[3]}); }
    __syncthreads();
}

__global__ void __launch_bounds__(NTHREADS, 2) mega_fwd(Args args) {
    extern __shared__ __attribute__((aligned(16))) unsigned char lds_raw[];
    cg::grid_group grid = cg::this_grid();
    Frame F;
    F.lds = (LAS unsigned char*)lds_raw; F.tid = threadIdx.x; F.lane = F.tid & 63; F.wave = __builtin_amdgcn_readfirstlane(F.tid >> 6); F.G = gridDim.x; F.bid = blockIdx.x;
    F.x = args.in[0]; F.norm1_pre = args.in[1]; F.w_in = args.in[2]; F.v_ln_g = args.in[3]; F.v_ln_b = args.in[4]; F.sgu_w = args.in[5]; F.sgu_b = args.in[6]; F.pool_w = args.in[7]; F.pool_scale = args.in[8];
    F.w_a = args.in[9]; F.w_b = args.in[10]; F.w_out = args.in[11]; F.norm1_post = args.in[12]; F.norm2_pre = args.in[13]; F.w_gate = args.in[14]; F.w_up = args.in[15]; F.w_down = args.in[16]; F.norm2_post = args.in[17];
    F.out = args.out; unsigned char* ws = args.ws;
    F.vsum = (float*)(ws + WS_STAT); F.vsq = F.vsum + M; F.st1 = F.vsum + 2 * M; F.st2 = F.vsum + 3 * M; F.st3 = F.vsum + 4 * M;
    F.WIN = (bf16*)(ws + WS_WIN); F.WAB = (bf16*)(ws + WS_WAB); F.WOUT = (bf16*)(ws + WS_WOUT); F.WGU = (bf16*)(ws + WS_WGU); F.WDN = (bf16*)(ws + WS_WDN); F.PWT = (bf16*)(ws + WS_PWT); F.SGW = (bf16*)(ws + WS_SGW);
    F.XN = (bf16*)(ws + WS_XN); F.XG = (bf16*)(ws + WS_XG); F.YA = F.XN; F.YB = F.XN + (size_t)M * DS; F.UV = (bf16*)(ws + WS_UV); F.MG = (bf16*)(ws + WS_XG);     F.P = (bf16*)(ws + WS_P); F.R = (bf16*)(ws + WS_R); F.GB = (bf16*)(ws + WS_GB); F.HID = (bf16*)(ws + WS_HID);

    if (F.tid < 16) ((LAS unsigned*)(F.lds + MISC_OFF))[F.tid] = 0u;
    __syncthreads();
    const XcdBarrier bar = xcd_barrier_post((unsigned*)(ws + WS_BAR), (volatile LAS unsigned*)(F.lds + MISC_OFF));
    if (args.out == nullptr) grid.sync();
    p0_prologue(F);
    if (PROBE_REP == 0) p0_prologue(F);
    if (PROBE_REP == 8) { for (int i = 0; i < 8; ++i) { xcd_barrier(bar); } }
    xcd_barrier(bar);
    constexpr int G1 = 224;
    unsigned* const tmo0 = (unsigned*)(ws + WS_BAR) + XB_TMO;
    unsigned* const lateW = (unsigned*)(ws + WS_BAR) + 30720;
    if (F.bid < G1) { pg8::Gemm g{F.XN, F.XN, F.WIN, F.WIN, M, DIN, D}; pg8::RangeOrder S; S.so.init(M, DIN, G1, F.bid);
      pg8::EpiIn E{F.UV, F.P, F.R, F.GB, F.vsum, F.vsq};
      S.base = 0; S.count = 2; pg8::gemm_phase<pg8::EpiIn, pg8::RangeOrder, true, true>(F.lds, g, S, E);
      if (F.tid == 0) { unsigned sp = 0; while (xb_ld(lateW) < (unsigned)((F.G - G1) * NWAVES)) { __builtin_amdgcn_s_sleep(1); if ((++sp & 255u) == 0u) { if (xb_ld(tmo0)) break; if (sp > XB_SPIN_CAP) { atomicAdd(tmo0, 1u); break; } } } }
      __syncthreads();
      S.base = 2; S.count = 2; pg8::gemm_phase<pg8::EpiIn, pg8::RangeOrder, true, true>(F.lds, g, S, E); }
    else { const int cw = (F.bid - G1) * NWAVES + F.wave, ncw = (F.G - G1) * NWAVES;
      convert_weights<3>(F, cw, ncw);
      asm volatile("s_waitcnt vmcnt(0)" ::: "memory"); if (F.lane == 0) (void)xb_add(lateW, 1u);
      convert_weights<1>(F, cw, ncw); }
    xcd_barrier(bar);
    pg8::Unit u0; { pg8::StaticOrder S0; S0.init(M, D, F.G, F.bid); S0.next(0, u0); }
    unsigned* const pwords = (unsigned*)(ws + WS_BAR) + PW_BASE + u0.pm * 64; unsigned* const tmo = (unsigned*)(ws + WS_BAR) + XB_TMO;
    for (int rep = 0; rep < (PROBE_REP == 2 ? 2 : 1); ++rep) {
        pool_unit(F, 2 * u0.pm + (u0.pn >> 2), u0.pn & 3);
        sgu_unit(F, 2 * u0.pm + (u0.pn >> 2), 2 * (u0.pn & 3)); sgu_unit(F, 2 * u0.pm + (u0.pn >> 2), 2 * (u0.pn & 3) + 1); }
    panel_barrier<false>(pwords + 0 * PW_SEAM, tmo);
    { pg8::Gemm g{F.YA, F.YB, F.WAB, F.WAB + (size_t)D * DS, M, D, DS}; pg8::PairOrder S; S.so.init(M, D, F.G, F.bid);
      pg8::EpiMerge E{F.R, F.GB, F.MG};
      if (PROBE_REP == 3) pg8::gemm_phase<pg8::EpiMerge, pg8::PairOrder, true, true>(F.lds, g, S, E);
      pg8::gemm_phase<pg8::EpiMerge, pg8::PairOrder, true, true>(F.lds, g, S, E); }
    panel_barrier<false>(pwords + 1 * PW_SEAM, tmo);
    { pg8::Gemm g{F.MG, F.MG, F.WOUT, F.WOUT, M, D, D}; pg8::StaticOrder S; S.init(M, D, F.G, F.bid);
      pg8::EpiNorm1 E{F.x, F.XG, F.norm1_post, F.st1, F.st2, pwords + 2 * PW_SEAM, tmo};
      if (PROBE_REP == 4) { pg8::EpiNull E0{(float*)(ws + WS_BAR + 131072)}; pg8::gemm_phase<pg8::EpiNull, pg8::StaticOrder, false, true>(F.lds, g, S, E0); }
      pg8::gemm_phase<pg8::EpiNorm1, pg8::StaticOrder, false, true>(F.lds, g, S, E); }
    xcd_barrier(bar);
    { pg8::Gemm g{F.XG, F.XG, F.WGU, F.WGU, M, 2 * FF, D}; pg8::IdxOrder S; S.so.init(M, 2 * FF, F.G, F.bid);
      LAS float* rsT = (LAS float*)(F.lds + 131072);
      if (F.tid < 256) { pg8::Unit uu; for (int i = 0; i < 8 && S.next(i, uu); ++i) rsT[i * 256 + F.tid] = __builtin_amdgcn_rsqf(F.st2[uu.pm * 256 + F.tid] * (1.f / D) + EPS); }
      __syncthreads();
      pg8::EpiSwiGLU E{F.HID, rsT};
      pg8::gemm_phase<pg8::EpiSwiGLU, pg8::IdxOrder, true, true>(F.lds, g, S, E); }
    { constexpr int U6 = (M / 256) * (2 * FF / 256), TAIL0 = U6 % 256;
      if (TAIL0 != 0 && F.bid >= TAIL0) convert_weights<2>(F, (F.bid - TAIL0) * NWAVES + F.wave, (F.G - TAIL0) * NWAVES);
      else if (TAIL0 == 0) convert_weights<2>(F, F.bid * NWAVES + F.wave, F.G * NWAVES); }
    xcd_barrier(bar);
    { pg8::Gemm g{F.HID, F.HID, F.WDN, F.WDN, M, D, FF}; pg8::StaticOrder S; S.init(M, D, F.G, F.bid);
      pg8::EpiNorm2 E{F.out, F.XG, F.norm2_post, F.st3, pwords + 3 * PW_SEAM, tmo};
      if (PROBE_REP == 7) { pg8::EpiNull E0{(float*)(ws + WS_BAR + 131072)}; pg8::gemm_phase<pg8::EpiNull, pg8::StaticOrder, false, true>(F.lds, g, S, E0); }
      pg8::gemm_phase<pg8::EpiNorm2, pg8::StaticOrder, false, true>(F.lds, g, S, E); }
}

extern "C" void kernel_launch(void* const* d_in, const int* in_sizes, int n_in, void* d_out, int out_size, void* d_ws, size_t ws_size, hipStream_t stream) {
    static int grid = 0;
    if (grid == 0) {
        if (n_in != 18 || in_sizes[0] != M * D || out_size != M * D || ws_size < WS_END) { fprintf(stderr, "kernel_launch: unexpected shapes (n_in %d, in0 %d, out %d, ws %zu); nothing launched\n", n_in, n_in > 0 ? in_sizes[0] : -1, out_size, ws_size); grid = -1; return; }
        int dev = 0, cus = 0, per_cu = 0;
        if (hipGetDevice(&dev) != hipSuccess || hipDeviceGetAttribute(&cus, hipDeviceAttributeMultiprocessorCount, dev) != hipSuccess) { grid = -1; return; }
        if (hipFuncSetAttribute((const void*)mega_fwd, hipFuncAttributeMaxDynamicSharedMemorySize, LDS_BYTES) != hipSuccess) { fprintf(stderr, "kernel_launch: hipFuncSetAttribute failed\n"); grid = -1; return; }
        if (hipOccupancyMaxActiveBlocksPerMultiprocessor(&per_cu, (const void*)mega_fwd, NTHREADS, LDS_BYTES) != hipSuccess || per_cu < 1) { fprintf(stderr, "kernel_launch: occupancy query reports %d blocks per CU\n", per_cu); (void)hipGetLastError(); grid = -1; return; }
        if (cus * per_cu < 256) { fprintf(stderr, "kernel_launch: needs 256 co-resident workgroups, device holds %d\n", cus * per_cu); grid = -1; return; }
        grid = 256;
    }
    if (grid < 0) return;
    Args a{};
    for (int i = 0; i < 18; ++i) a.in[i] = (const float*)d_in[i];
    a.out = (float*)d_out; a.ws = (unsigned char*)d_ws;
    if (hipMemsetAsync((char*)d_ws + WS_BAR, 0, 65536, stream) != hipSuccess) { fprintf(stderr, "kernel_launch: memset failed\n"); return; }
    void* kargs[] = {&a};
    hipError_t e = hipLaunchCooperativeKernel((const void*)mega_fwd, dim3(grid), dim3(NTHREADS), kargs, LDS_BYTES, stream);
    if (e != hipSuccess) fprintf(stderr, "kernel_launch: cooperative launch failed: %s\n", hipGetErrorString(e));
}
```

```cpp
#ifndef PROBE_REP
#define PROBE_REP -1
#endif
#include <hip/hip_runtime.h>
#include <hip/hip_cooperative_groups.h>
#include <cstdio>
#include <cstdint>
namespace cg = cooperative_groups;
#define LAS __attribute__((address_space(3)))
#define XB_TMO      128
#define XB_XCNT(j)  (256  + 64 * (j))
#define XB_XSUB(j)  (1280 + 64 * (j))
#define XB_XGEN(j)  (2304 + 64 * (j))
#define XB_TOP      3328
#define XB_TOPGEN   3392
#define XCD_BAR_WORDS 3456
#define XB_SPIN_CAP (1u << 18)

__device__ __forceinline__ unsigned xb_ld(unsigned* p)              { return __hip_atomic_load(p, __ATOMIC_RELAXED, __HIP_MEMORY_SCOPE_AGENT); }
__device__ __forceinline__ unsigned xb_add(unsigned* p, unsigned v) { return __hip_atomic_fetch_add(p, v, __ATOMIC_RELAXED, __HIP_MEMORY_SCOPE_AGENT); }
__device__ __forceinline__ unsigned xb_xcc_id() { return (unsigned)__builtin_amdgcn_s_getreg((3 << 11) | 20) & 0xFu; }
#define XB_SPIN(cond, bar) do { unsigned _sp = 0; while (cond) { __builtin_amdgcn_s_sleep(1); \
    if ((++_sp & 255u) == 0u) { if (xb_ld(&(bar)[XB_TMO])) break; if (_sp > XB_SPIN_CAP) { atomicAdd(&(bar)[XB_TMO], 1u); break; } } } } while (0)

struct XcdBarrier {
    unsigned* bar; unsigned x;
    volatile LAS unsigned* st;
};

__device__ __forceinline__ XcdBarrier xcd_barrier_post(unsigned* bar, volatile LAS unsigned* st) {
    XcdBarrier b; b.bar = bar; b.x = xb_xcc_id(); b.st = st;
    if (threadIdx.x == 0) (void)xb_add(&bar[XB_XCNT(b.x)], 1u);
    return b;
}
__device__ __forceinline__ void xcd_barrier_complete(unsigned* bar, unsigned x, unsigned& nloc, unsigned& nx) {
    const unsigned G = gridDim.x * gridDim.y * gridDim.z;
    unsigned sum, cnt, mine, sp = 0u;
    for (;;) {
        sum = 0u; cnt = 0u; mine = 0u;
#pragma unroll
        for (unsigned j = 0; j < 16; ++j) { const unsigned c = xb_ld(&bar[XB_XCNT(j)]); sum += c; cnt += (c > 0u) ? 1u : 0u; mine = (j == x) ? c : mine; }
        if (sum == G) break;
        __builtin_amdgcn_s_sleep(1);
        if ((++sp & 255u) == 0u) { if (xb_ld(&bar[XB_TMO])) break; if (sp > XB_SPIN_CAP) { atomicAdd(&bar[XB_TMO], 1u); break; } }
    }
    nloc = mine > 0u ? mine : 1u; nx = cnt > 0u ? cnt : 1u;
}

__device__ __forceinline__ void xcd_barrier(const XcdBarrier& b) {
    asm volatile("s_waitcnt vmcnt(0)" ::: "memory");
    __syncthreads();
    if (threadIdx.x == 0) {
        unsigned* bar = b.bar;
        __builtin_amdgcn_s_waitcnt(0);
        unsigned nloc = b.st[0], nx = b.st[1];
        if (nloc == 0u) { xcd_barrier_complete(bar, b.x, nloc, nx); b.st[0] = nloc; b.st[1] = nx; }
        const unsigned old = xb_add(&bar[XB_XSUB(b.x)], 1u);
        const unsigned gen = old / nloc;
        if (old + 1u == (gen + 1u) * nloc) {
            __builtin_amdgcn_fence(__ATOMIC_RELEASE, "agent");
            asm volatile("s_waitcnt vmcnt(0)" ::: "memory");
            const unsigned og = xb_add(&bar[XB_TOP], 1u);
            const unsigned tg = og / nx;
            if (og + 1u == (tg + 1u) * nx) xb_add(&bar[XB_TOPGEN], 1u);
            else XB_SPIN(xb_ld(&bar[XB_TOPGEN]) == tg, bar);
            __builtin_amdgcn_fence(__ATOMIC_ACQUIRE, "agent");
            xb_add(&bar[XB_XGEN(b.x)], 1u);
            asm volatile("s_waitcnt vmcnt(0)" ::: "memory");
        } else {
            XB_SPIN(xb_ld(&bar[XB_XGEN(b.x)]) == gen, bar);
            __builtin_amdgcn_fence(__ATOMIC_ACQUIRE, "agent");
            asm volatile("s_waitcnt vmcnt(0)" ::: "memory");
        }
    }
    __syncthreads();
}


template <bool ACQ>
__device__ __forceinline__ void panel_barrier(unsigned* word, unsigned* tmo) {
    asm volatile("s_waitcnt vmcnt(0)" ::: "memory");
    __syncthreads();
    if (threadIdx.x == 0) {
        (void)xb_add(word, 1u);
        unsigned sp = 0;
        while (xb_ld(word) < 8u) { __builtin_amdgcn_s_sleep(1); if ((++sp & 255u) == 0u) { if (xb_ld(tmo)) break; if (sp > XB_SPIN_CAP) { atomicAdd(tmo, 1u); break; } } }
        if (ACQ) { __builtin_amdgcn_fence(__ATOMIC_ACQUIRE, "agent"); asm volatile("s_waitcnt vmcnt(0)" ::: "memory"); }
    }
    __syncthreads();
}
typedef unsigned wt_u32x4 __attribute__((ext_vector_type(4)));
typedef unsigned wt_u32x2 __attribute__((ext_vector_type(2)));
__device__ __forceinline__ void st16_wt(void* p, wt_u32x4 v) { asm volatile("global_store_dwordx4 %0, %1, off sc1\n\ts_nop 1" : : "v"(p), "v"(v) : "memory"); }
__device__ __forceinline__ void st8_wt(void* p, wt_u32x2 v) { asm volatile("global_store_dwordx2 %0, %1, off sc1" : : "v"(p), "v"(v) : "memory"); }
namespace pg8 {
#define PG8_LAS __attribute__((address_space(3)))
typedef unsigned short bf16_t;
typedef short bf16x8 __attribute__((ext_vector_type(8)));
typedef float f32x4 __attribute__((ext_vector_type(4)));
typedef unsigned u32x4 __attribute__((ext_vector_type(4)));
constexpr int BM = 256, BK = 64, HALF = 128, HTB = HALF * BK * 2  , STAGE_BYTES = 8 * HTB, NXCD = 8, WGM = 8;

__host__ __device__ __forceinline__ int lds_byte(int r, int c) { const int st = (r >> 4) * 2 + (c >> 5), rr = r & 15, cc = c & 31, ob = rr * 64 + cc * 2; return st * 1024 + (ob ^ (((ob >> 9) & 1) << 5)); }
__host__ __device__ __forceinline__ void stage_rc(int b, int& R, int& C) { const int st = b / 1024, sb = b % 1024, swz = sb ^ (((sb >> 9) & 1) << 5); R = (st >> 1) * 16 + swz / 64; C = (st & 1) * 32 + (swz % 64) / 2; }
__host__ __device__ __forceinline__ int perm32(int rho) { const int n = rho >> 4, i = rho & 15; return 8 * (i >> 2) + 4 * n + (i & 3); }

struct Unit { int pm, pn, z; };
struct Gemm { const bf16_t *A0, *A1, *B0, *B1; int M, N, K; };

struct StaticOrder {
    int nM, nN, nwg, G, c;
    __host__ __device__ void init(int M, int N, int G_, int c_) { nM = M / BM; nN = N / BM; nwg = nM * nN; G = G_; c = c_; }
    __host__ __device__ bool next(int i, Unit& u) const {
        const long L = (long)i * G + c; if (L >= nwg) return false;
        int wgid = (int)L; { const int q = nwg / NXCD, r = nwg % NXCD, xcd = wgid % NXCD, off = wgid / NXCD; wgid = (xcd < r ? xcd * (q + 1) : r * (q + 1) + (xcd - r) * q) + off; }
        const int nig = WGM * nN, gid = wgid / nig, fm = gid * WGM, gsz = (nM - fm) < WGM ? (nM - fm) : WGM;
        u.pm = fm + ((wgid % nig) % gsz); u.pn = (wgid % nig) / gsz; u.z = 0; return true;
    }
    __device__ __forceinline__ void a_ready(const Unit&) const {}
    __device__ __forceinline__ void done(const Unit&) const {}
};

typedef float f32x2 __attribute__((ext_vector_type(2)));
typedef unsigned u32x2 __attribute__((ext_vector_type(2)));
__device__ __forceinline__ unsigned cvt_pk_bf16(float lo, float hi) { unsigned r; asm volatile("v_cvt_pk_bf16_f32 %0, %1, %2" : "=v"(r) : "v"(lo), "v"(hi)); return r; }
__device__ __forceinline__ float bf_lo(unsigned w) { return __uint_as_float(w << 16); }
__device__ __forceinline__ float bf_hi(unsigned w) { return __uint_as_float(w & 0xffff0000u); }
__device__ __forceinline__ f32x2 gelu_pk(f32x2 v) {
    const f32x2 av = __builtin_elementwise_abs(v), d = av * 0.2316418882f + 1.0f;
    f32x2 t; t.x = __builtin_amdgcn_rcpf(d.x); t.y = __builtin_amdgcn_rcpf(d.y);
    f32x2 q = t * 0.5307027145f + (-0.7265760135f); q = q * t + 0.7107068705f; q = q * t + (-0.142248368f); q = q * t + 0.127414796f; q = q * t;
    const f32x2 s = (v * v) * (-0.72134752044f);
    f32x2 e; e.x = __builtin_amdgcn_exp2f(s.x); e.y = __builtin_amdgcn_exp2f(s.y);
    const f32x2 m = v * (q * e), r = v - m;
    f32x2 o; o.x = v.x < 0.f ? m.x : r.x; o.y = v.y < 0.f ? m.y : r.y; return o;
}
__device__ __forceinline__ f32x4 gelu4(f32x4 v) { f32x2 a = gelu_pk((f32x2){v[0], v[1]}), b = gelu_pk((f32x2){v[2], v[3]}); return (f32x4){a.x, a.y, b.x, b.y}; }
__device__ __forceinline__ float exp_neg(float x) { return __builtin_amdgcn_exp2f(fminf(-x * 1.44269504089f, 100.f)); }
__device__ __forceinline__ float ld_agent(const float* p) { return __hip_atomic_load(p, __ATOMIC_RELAXED, __HIP_MEMORY_SCOPE_AGENT); }
__device__ __forceinline__ u32x4 pack8(f32x4 a, f32x4 b) { u32x4 w; w.x = cvt_pk_bf16(a[0], a[1]); w.y = cvt_pk_bf16(a[2], a[3]); w.z = cvt_pk_bf16(b[0], b[1]); w.w = cvt_pk_bf16(b[2], b[3]); return w; }
__device__ __forceinline__ void unpack8(u32x4 w, f32x4& a, f32x4& b) { a = (f32x4){bf_lo(w.x), bf_hi(w.x), bf_lo(w.y), bf_hi(w.y)}; b = (f32x4){bf_lo(w.z), bf_hi(w.z), bf_lo(w.w), bf_hi(w.w)}; }

constexpr int D_ = 2048, DS_ = 1024, FF_ = 5632;
constexpr float EPS_ = 1e-6f;
struct EpiIn {
    static constexpr bool PERM = true, AFTER_DRAIN = false, KEEP = false;
    bf16_t *UV, *P, *R, *GB; float *vsum, *vsq;
    __device__ __forceinline__ void operator()(f32x4 (&acc)[2][2][4][2], const Unit& u, int wr, int wc, int fr, int fq) const {
        const int row0 = u.pm * BM + wr * 64 + fr, cl = wc * 32 + 8 * fq;
        if (u.pn < 8) {
            const bool isv = u.pn >= 4;
#pragma unroll
            for (int ai = 0; ai < 2; ++ai)
#pragma unroll
                for (int m = 0; m < 4; ++m) { const int row = row0 + ai * HALF + m * 16; float s = 0.f, q = 0.f;
#pragma unroll
                    for (int bj = 0; bj < 2; ++bj) { const f32x4 a = gelu4(acc[ai][bj][m][0]), b = gelu4(acc[ai][bj][m][1]);
                        s += ((a[0] + a[1]) + (a[2] + a[3])) + ((b[0] + b[1]) + (b[2] + b[3]));
                        q += ((a[0] * a[0] + a[1] * a[1]) + (a[2] * a[2] + a[3] * a[3])) + ((b[0] * b[0] + b[1] * b[1]) + (b[2] * b[2] + b[3] * b[3]));
                        *(u32x4*)(UV + (size_t)row * D_ + u.pn * BM + bj * HALF + cl) = pack8(a, b); }
                    if (isv) { s += __shfl_xor(s, 16); s += __shfl_xor(s, 32); q += __shfl_xor(q, 16); q += __shfl_xor(q, 32);
                        if (fq == 0) { atomicAdd(vsum + row, s); atomicAdd(vsq + row, q); } } }
        } else if (u.pn < 12) {
#pragma unroll
            for (int ai = 0; ai < 2; ++ai)
#pragma unroll
                for (int m = 0; m < 4; ++m) { const int row = row0 + ai * HALF + m * 16;
#pragma unroll
                    for (int bj = 0; bj < 2; ++bj) *(u32x4*)(P + (size_t)row * DS_ + (u.pn - 8) * BM + bj * HALF + cl) = pack8(acc[ai][bj][m][0], acc[ai][bj][m][1]); }
        } else {
            const int ch = (u.pn - 12) * HALF + cl;
#pragma unroll
            for (int ai = 0; ai < 2; ++ai)
#pragma unroll
                for (int m = 0; m < 4; ++m) { const int row = row0 + ai * HALF + m * 16; f32x4 r[2], g[2];
#pragma unroll
                    for (int n = 0; n < 2; ++n)
#pragma unroll
                        for (int e = 0; e < 4; ++e) { const float ea = exp_neg(acc[ai][0][m][n][e]), eb = exp_neg(acc[ai][1][m][n][e]);
                            const float ia = __builtin_amdgcn_rcpf(1.f + ea), ib = __builtin_amdgcn_rcpf(1.f + eb);
                            r[n][e] = (1.f + eb) * ia; g[n][e] = ib; }
                    *(u32x4*)(R + (size_t)row * D_ + ch) = pack8(r[0], r[1]); *(u32x4*)(GB + (size_t)row * D_ + ch) = pack8(g[0], g[1]); }
        }
    }
};
struct EpiMerge {
    static constexpr bool PERM = true, AFTER_DRAIN = false, KEEP = true;
    const bf16_t *R, *GB; bf16_t* MG;
    __device__ __forceinline__ void operator()(f32x4 (&acc)[2][2][4][2], const Unit& u, int wr, int wc, int fr, int fq) const {
        const int row0 = u.pm * BM + wr * 64 + fr, cl = u.pn * BM + wc * 32 + 8 * fq;
#pragma unroll
        for (int ai = 0; ai < 2; ++ai)
#pragma unroll
            for (int m = 0; m < 4; ++m) { const size_t off = (size_t)(row0 + ai * HALF + m * 16) * D_ + cl;
#pragma unroll
                for (int bj = 0; bj < 2; ++bj) {
                    if (u.z == 0) { f32x4 a, b; unpack8(*(const u32x4*)(R + off + bj * HALF), a, b); acc[ai][bj][m][0] *= a; acc[ai][bj][m][1] *= b; }
                    else { f32x4 a, b; unpack8(*(const u32x4*)(GB + off + bj * HALF), a, b); st16_wt(MG + off + bj * HALF, pack8(acc[ai][bj][m][0] * a, acc[ai][bj][m][1] * b)); } } }
    }
};
struct EpiSwiGLU {
    static constexpr bool PERM = true, AFTER_DRAIN = false, KEEP = false;
    bf16_t* H; const PG8_LAS float* rsT;
    __device__ __forceinline__ void operator()(f32x4 (&acc)[2][2][4][2], const Unit& u, int wr, int wc, int fr, int fq) const {
        const int row0 = u.pm * BM + wr * 64 + fr, cl = u.pn * HALF + wc * 32 + 8 * fq;
#pragma unroll
        for (int ai = 0; ai < 2; ++ai)
#pragma unroll
            for (int m = 0; m < 4; ++m) { f32x4 o[2]; const float rs = rsT[u.z * BM + wr * 64 + fr + ai * HALF + m * 16];
#pragma unroll
                for (int n = 0; n < 2; ++n)
#pragma unroll
                    for (int e = 0; e < 4; ++e) { const float g = acc[ai][0][m][n][e] * rs; o[n][e] = g * __builtin_amdgcn_rcpf(1.f + exp_neg(g)) * (acc[ai][1][m][n][e] * rs); }
                *(u32x4*)(H + (size_t)(row0 + ai * HALF + m * 16) * FF_ + cl) = pack8(o[0], o[1]); }
    }
};
__device__ __forceinline__ void row_sumsq_add(const f32x4 (&v)[2][2][4][2], float* st, int row0, int fq) {
#pragma unroll
    for (int ai = 0; ai < 2; ++ai)
#pragma unroll
        for (int m = 0; m < 4; ++m) { float s = 0.f;
#pragma unroll
            for (int bj = 0; bj < 2; ++bj)
#pragma unroll
                for (int n = 0; n < 2; ++n) { const f32x4 x = v[ai][bj][m][n]; s += (x[0] * x[0] + x[1] * x[1]) + (x[2] * x[2] + x[3] * x[3]); }
            s += __shfl_xor(s, 16); s += __shfl_xor(s, 32);
            if (fq == 0) atomicAdd(st + row0 + ai * HALF + m * 16, s); }
}
struct EpiNorm1 {
    static constexpr bool PERM = false, AFTER_DRAIN = true, KEEP = false;
    const float* x; bf16_t* xg; const float* g1; float *st1, *st2; unsigned *pword, *tmo;
    __device__ __forceinline__ void fused(f32x4 (&acc)[2][2][4][2], const Unit& u, int wr, int wc, int fr, int fq, PG8_LAS unsigned char* lds, int wid, int lane) const {
        const int row0 = u.pm * BM + wr * 64 + fr, col0 = u.pn * BM + wc * 32 + 4 * fq;
        row_sumsq_add(acc, st1, row0, fq);
        panel_barrier<false>(pword, tmo);
#pragma unroll
        for (int ai = 0; ai < 2; ++ai)
#pragma unroll
            for (int m = 0; m < 4; ++m) { const int row = row0 + ai * HALF + m * 16; const float rs = __builtin_amdgcn_rsqf(ld_agent(st1 + row) * (1.f / D_) + EPS_);
#pragma unroll
                for (int bj = 0; bj < 2; ++bj)
#pragma unroll
                    for (int n = 0; n < 2; ++n) { const size_t off = (size_t)row * D_ + col0 + bj * HALF + n * 16; const f32x4 g = *(const f32x4*)(g1 + col0 + bj * HALF + n * 16);
                        const f32x4 v = *(const f32x4*)(x + off) + acc[ai][bj][m][n] * rs * g; acc[ai][bj][m][n] = v;
                        u32x2 w; w.x = cvt_pk_bf16(v[0], v[1]); w.y = cvt_pk_bf16(v[2], v[3]);
                        *(PG8_LAS u32x2*)(lds + (wr * 64 + fr + ai * HALF + m * 16) * 528 + (wc * 32 + 4 * fq + bj * HALF + n * 16) * 2) = w; }
                asm volatile("" ::: "memory"); }
        row_sumsq_add(acc, st2, row0, fq);
        asm volatile("s_waitcnt lgkmcnt(0)" ::: "memory"); __builtin_amdgcn_s_barrier(); asm volatile("" ::: "memory");
        const int tid = wid * 64 + lane;
#pragma unroll
        for (int k = 0; k < 16; ++k) { const int q = tid + 512 * k, row = q >> 5, ch = q & 31;
            *(u32x4*)(xg + (size_t)(u.pm * BM + row) * D_ + u.pn * BM + 8 * ch) = *(const PG8_LAS u32x4*)(lds + row * 528 + ch * 16); }
    }
};
struct EpiNorm2 {
    static constexpr bool PERM = false, AFTER_DRAIN = true, KEEP = false;
    float* out; const bf16_t* x1b; const float* g3; float* st3; unsigned *pword, *tmo;
    __device__ __forceinline__ void fused(f32x4 (&acc)[2][2][4][2], const Unit& u, int wr, int wc, int fr, int fq, PG8_LAS unsigned char*, int, int) const {
        const int row0 = u.pm * BM + wr * 64 + fr, col0 = u.pn * BM + wc * 32 + 4 * fq;
        row_sumsq_add(acc, st3, row0, fq);
        panel_barrier<false>(pword, tmo);
#pragma unroll
        for (int ai = 0; ai < 2; ++ai)
#pragma unroll
            for (int m = 0; m < 4; ++m) { const int row = row0 + ai * HALF + m * 16; const float rs = __builtin_amdgcn_rsqf(ld_agent(st3 + row) * (1.f / D_) + EPS_);
#pragma unroll
                for (int bj = 0; bj < 2; ++bj)
#pragma unroll
                    for (int n = 0; n < 2; ++n) { const size_t off = (size_t)row * D_ + col0 + bj * HALF + n * 16; const f32x4 g = *(const f32x4*)(g3 + col0 + bj * HALF + n * 16);
                        const u32x2 xb = *(const u32x2*)(x1b + off); const f32x4 x1v = (f32x4){bf_lo(xb.x), bf_hi(xb.x), bf_lo(xb.y), bf_hi(xb.y)};
                        *(f32x4*)(out + off) = x1v + acc[ai][bj][m][n] * rs * g; }
                asm volatile("" ::: "memory"); }
    }
};
struct EpiNull {
    static constexpr bool PERM = false, AFTER_DRAIN = false, KEEP = false;
    float* sink;
    __device__ __forceinline__ void operator()(f32x4 (&acc)[2][2][4][2], const Unit& u, int wr, int wc, int fr, int fq) const {
        float s = 0.f;
#pragma unroll
        for (int ai = 0; ai < 2; ++ai)
#pragma unroll
            for (int m = 0; m < 4; ++m)
#pragma unroll
                for (int bj = 0; bj < 2; ++bj)
#pragma unroll
                    for (int n = 0; n < 2; ++n) s += acc[ai][bj][m][n][0] + acc[ai][bj][m][n][1] + acc[ai][bj][m][n][2] + acc[ai][bj][m][n][3];
        if (s == 1234.5678f) sink[0] = s;
    }
};
struct IdxOrder {
    StaticOrder so;
    __device__ bool next(int i, Unit& u) const { if (!so.next(i, u)) return false; u.z = i; return true; }
    __device__ __forceinline__ void a_ready(const Unit&) const {}
    __device__ __forceinline__ void done(const Unit&) const {}
};
struct RangeOrder {
    StaticOrder so; int base, count;
    __device__ bool next(int i, Unit& u) const { return i < count && so.next(base + i, u); }
    __device__ __forceinline__ void a_ready(const Unit&) const {}
    __device__ __forceinline__ void done(const Unit&) const {}
};
struct PairOrder {
    StaticOrder so;
    __device__ bool next(int i, Unit& u) const { if (!so.next(i >> 1, u)) return false; u.z = i & 1; return true; }
    __device__ __forceinline__ void a_ready(const Unit&) const {}
    __device__ __forceinline__ void done(const Unit&) const {}
};
template <class Epi, class Sched, bool ALIGN_EPI = false, bool SP2 = false>
__device__ __forceinline__ void gemm_phase(PG8_LAS unsigned char* lds, const Gemm g, const Sched& S, const Epi& E) {
    const int tid = threadIdx.x, wid = __builtin_amdgcn_readfirstlane(tid >> 6), lane = tid & 63, wr = wid >> 2, wc = wid & 3, fr = lane & 15, fq = lane >> 4;
    const int K = g.K, nt = K / BK;
    unsigned voffA[2], voffB[2];
#pragma unroll
    for (int i = 0; i < 2; ++i) { int R, C; stage_rc(tid * 16 + i * 8192, R, C); const int Rb = Epi::PERM ? ((R & ~31) + perm32(R & 31)) : R;
        voffA[i] = (unsigned)(R * K + C) * 2u; voffB[i] = (unsigned)(Rb * K + C) * 2u; }
    const size_t kstep = (size_t)(BK * 2);
    const size_t hstep = (size_t)HALF * K * 2;
    const size_t tstep = 2 * hstep;
    const unsigned ldsw = (unsigned)wid * 1024u;
    const int aoff = lds_byte(wr * 64 + fr, fq * 8), boff = lds_byte(wc * 32 + fr, fq * 8);
#define PG8_SA(b, h) (((b) * 2 + (h)) * HTB)
#define PG8_SB(b, h) ((4 + (b) * 2 + (h)) * HTB)
#define PG8_STAGE(bufoff, gbase, voff) do { _Pragma("unroll") for (int _i = 0; _i < 2; ++_i) \
        __builtin_amdgcn_global_load_lds((const unsigned*)((const char*)(gbase) + (voff)[_i]), (PG8_LAS unsigned*)(lds + (bufoff) + ldsw + _i * 8192), 16, 0, 0); } while (0)
#define PG8_LDA(dst, b, h) do { _Pragma("unroll") for (int m = 0; m < 4; ++m) _Pragma("unroll") for (int k = 0; k < 2; ++k) dst[m][k] = *(const PG8_LAS bf16x8*)(lds + PG8_SA(b, h) + aoff + m * 2048 + k * 1024); } while (0)
#define PG8_LDB(dst, b, h) do { _Pragma("unroll") for (int n = 0; n < 2; ++n) _Pragma("unroll") for (int k = 0; k < 2; ++k) dst[n][k] = *(const PG8_LAS bf16x8*)(lds + PG8_SB(b, h) + boff + n * 2048 + k * 1024); } while (0)
#define PG8_MMA(ai, bj, At, Bt) do { __builtin_amdgcn_s_setprio(1); _Pragma("unroll") for (int m = 0; m < 4; ++m) _Pragma("unroll") for (int n = 0; n < 2; ++n) _Pragma("unroll") for (int k = 0; k < 2; ++k) \
        acc[ai][bj][m][n] = __builtin_amdgcn_mfma_f32_16x16x32_bf16(Bt[n][k], At[m][k], acc[ai][bj][m][n], 0, 0, 0); __builtin_amdgcn_s_setprio(0); } while (0)
#define PG8_WAIT_V(n) asm volatile("s_waitcnt vmcnt(" #n ")" ::: "memory")
#define PG8_WAIT_L(n) asm volatile("s_waitcnt lgkmcnt(" #n ")" ::: "memory")
#define PG8_BAR __builtin_amdgcn_s_barrier()
#define PG8_SCHED __builtin_amdgcn_sched_barrier(0)
    Unit cur, nxt; int ui = 0;
    if (!S.next(0, cur)) return;
    f32x4 acc[2][2][4][2];
#pragma unroll
    for (int a = 0; a < 2; ++a)
#pragma unroll
        for (int b = 0; b < 2; ++b)
#pragma unroll
            for (int m = 0; m < 4; ++m)
#pragma unroll
                for (int n = 0; n < 2; ++n) acc[a][b][m][n] = (f32x4){0.f, 0.f, 0.f, 0.f};
    bf16x8 At[4][2], B0[2][2], B1[2][2];
    const char* cA = (const char*)(cur.z ? g.A1 : g.A0) + (size_t)cur.pm * tstep; const char* cB = (const char*)(cur.z ? g.B1 : g.B0) + (size_t)cur.pn * tstep;
    S.a_ready(cur);
    if constexpr (SP2) {
        PG8_STAGE(PG8_SB(0, 0), cB, voffB); PG8_STAGE(PG8_SB(0, 1), cB + hstep, voffB); PG8_STAGE(PG8_SA(0, 0), cA, voffA); PG8_STAGE(PG8_SA(0, 1), cA + hstep, voffA);
        if (wr == 1) PG8_BAR;
        PG8_WAIT_V(2); PG8_BAR;
        PG8_STAGE(PG8_SB(1, 0), cB + kstep, voffB); PG8_STAGE(PG8_SA(1, 0), cA + kstep, voffA); PG8_STAGE(PG8_SB(1, 1), cB + hstep + kstep, voffB);
        PG8_WAIT_V(6); PG8_BAR;
    } else {
        PG8_STAGE(PG8_SB(0, 0), cB, voffB); PG8_STAGE(PG8_SA(0, 0), cA, voffA); PG8_STAGE(PG8_SB(0, 1), cB + hstep, voffB); PG8_STAGE(PG8_SA(0, 1), cA + hstep, voffA);
        if (wr == 1) PG8_BAR;
        PG8_WAIT_V(4); PG8_BAR;
        PG8_STAGE(PG8_SB(1, 0), cB + kstep, voffB); PG8_STAGE(PG8_SA(1, 0), cA + kstep, voffA); PG8_STAGE(PG8_SB(1, 1), cB + hstep + kstep, voffB);
        PG8_WAIT_V(6); PG8_BAR;
    }
    for (;;) {
        const bool has_next = S.next(ui + 1, nxt);
        const char* nA = has_next ? (const char*)(nxt.z ? g.A1 : g.A0) + (size_t)nxt.pm * tstep : cA; const char* nB = has_next ? (const char*)(nxt.z ? g.B1 : g.B0) + (size_t)nxt.pn * tstep : cB;
        for (int t = 0; t < nt; t += 2) {
            const bool last = (t == nt - 2);
            const char* a1 = cA + (size_t)(t + 1) * kstep;
            const char* a2 = last ? nA : cA + (size_t)(t + 2) * kstep; const char* b2 = last ? nB : cB + (size_t)(t + 2) * kstep;
            const char* a3 = a2 + kstep; const char* b3 = b2 + kstep;
            if (last && has_next) S.a_ready(nxt);
            if constexpr (SP2) {
            PG8_LDB(B0, 0, 0); PG8_LDB(B1, 0, 1); PG8_SCHED; PG8_LDA(At, 0, 0); PG8_STAGE(PG8_SA(1, 1), a1 + hstep, voffA);
            PG8_WAIT_V(8); PG8_WAIT_L(0); PG8_BAR; PG8_MMA(0, 0, At, B0); PG8_MMA(0, 1, At, B1); PG8_BAR; PG8_SCHED;
            PG8_LDA(At, 0, 1); PG8_STAGE(PG8_SB(0, 0), b2, voffB); PG8_STAGE(PG8_SB(0, 1), b2 + hstep, voffB); PG8_STAGE(PG8_SA(0, 0), a2, voffA);
            PG8_WAIT_V(8); PG8_WAIT_L(0); PG8_BAR; PG8_MMA(1, 0, At, B0); PG8_MMA(1, 1, At, B1); PG8_BAR; PG8_SCHED;
            PG8_LDB(B0, 1, 0); PG8_LDB(B1, 1, 1); PG8_SCHED; PG8_LDA(At, 1, 0); PG8_STAGE(PG8_SA(0, 1), a2 + hstep, voffA);
            PG8_WAIT_V(8); PG8_WAIT_L(0); PG8_BAR; PG8_MMA(0, 0, At, B0); PG8_MMA(0, 1, At, B1); PG8_BAR; PG8_SCHED;
            PG8_LDA(At, 1, 1); PG8_STAGE(PG8_SB(1, 0), b3, voffB); PG8_STAGE(PG8_SB(1, 1), b3 + hstep, voffB); PG8_STAGE(PG8_SA(1, 0), a3, voffA);
            PG8_WAIT_V(8); PG8_WAIT_L(0); PG8_BAR; PG8_MMA(1, 0, At, B0); PG8_MMA(1, 1, At, B1); PG8_BAR; PG8_SCHED;
            } else {
            PG8_LDB(B0, 0, 0); PG8_SCHED; PG8_LDA(At, 0, 0); PG8_STAGE(PG8_SA(1, 1), a1 + hstep, voffA);
            PG8_WAIT_L(8); PG8_BAR; PG8_WAIT_L(0); PG8_MMA(0, 0, At, B0); PG8_BAR; PG8_SCHED;
            PG8_LDB(B1, 0, 1); PG8_STAGE(PG8_SB(0, 0), b2, voffB);
            PG8_BAR; PG8_WAIT_L(0); PG8_MMA(0, 1, At, B1); PG8_BAR;
            PG8_LDA(At, 0, 1); PG8_STAGE(PG8_SA(0, 0), a2, voffA);
            PG8_BAR; PG8_WAIT_L(0); PG8_MMA(1, 0, At, B0); PG8_BAR; PG8_SCHED;
            PG8_STAGE(PG8_SB(0, 1), b2 + hstep, voffB);
            PG8_WAIT_V(6); PG8_BAR; PG8_MMA(1, 1, At, B1); PG8_BAR;
            PG8_LDB(B0, 1, 0); PG8_SCHED; PG8_LDA(At, 1, 0); PG8_STAGE(PG8_SA(0, 1), a2 + hstep, voffA);
            PG8_WAIT_L(8); PG8_BAR; PG8_WAIT_L(0); PG8_MMA(0, 0, At, B0); PG8_BAR; PG8_SCHED;
            PG8_LDB(B1, 1, 1); PG8_STAGE(PG8_SB(1, 0), b3, voffB);
            PG8_BAR; PG8_WAIT_L(0); PG8_MMA(0, 1, At, B1); PG8_BAR;
            PG8_LDA(At, 1, 1); PG8_STAGE(PG8_SA(1, 0), a3, voffA);
            PG8_BAR; PG8_WAIT_L(0); PG8_MMA(1, 0, At, B0); PG8_BAR; PG8_SCHED;
            PG8_STAGE(PG8_SB(1, 1), b3 + hstep, voffB);
            PG8_WAIT_V(6); PG8_BAR; PG8_MMA(1, 1, At, B1); PG8_BAR;
            }
        }
        if constexpr (ALIGN_EPI) { if (wr == 0) PG8_BAR; }
        if constexpr (!Epi::AFTER_DRAIN) { E(acc, cur, wr, wc, fr, fq); S.done(cur); }
        if (!has_next) break;
        if (!(Epi::KEEP && cur.z == 0))
#pragma unroll
        for (int a = 0; a < 2; ++a)
#pragma unroll
            for (int b = 0; b < 2; ++b)
#pragma unroll
                for (int m = 0; m < 4; ++m)
#pragma unroll
                    for (int n = 0; n < 2; ++n) acc[a][b][m][n] = (f32x4){0.f, 0.f, 0.f, 0.f};
        cur = nxt; cA = nA; cB = nB; ++ui;
        if constexpr (ALIGN_EPI) { if (wr == 1) PG8_BAR; }
    }
    PG8_WAIT_V(0);
    if constexpr (!ALIGN_EPI) { if (wr == 0) PG8_BAR; }
    PG8_BAR;
    if constexpr (Epi::AFTER_DRAIN) { E.fused(acc, cur, wr, wc, fr, fq, lds, wid, lane); S.done(cur); }
#undef PG8_SA
#undef PG8_SB
#undef PG8_STAGE
#undef PG8_LDA
#undef PG8_LDB
#undef PG8_MMA
#undef PG8_WAIT_V
#undef PG8_WAIT_L
#undef PG8_BAR
#undef PG8_SCHED
}
}

constexpr int NWAVES = 8, NTHREADS = 512;
constexpr int SEQ = 4096, M = 8192, D = 2048, DS = 1024, DP = 1024, DIN = 7168, FF = 5632;
constexpr float EPS = 1e-6f;
constexpr size_t MiB = 1u << 20;
constexpr size_t WS_STAT = 0;
constexpr size_t WS_BAR = 1 * MiB;
constexpr int PW_BASE = 4096, PW_SEAM = 32 * 64;
constexpr size_t WS_WIN = 2 * MiB;
constexpr size_t WS_XG = 2 * MiB;
constexpr size_t WS_WAB = 34 * MiB;
constexpr size_t WS_WOUT = 42 * MiB;
constexpr size_t WS_WGU = 50 * MiB;
constexpr size_t WS_WDN = 94 * MiB;
constexpr size_t WS_PWT = 116 * MiB;
constexpr size_t WS_SGW = 116 * MiB + 512 * 1024;
constexpr size_t WS_XN = 117 * MiB;
constexpr size_t WS_UV = 149 * MiB;
constexpr size_t WS_P = 181 * MiB;
constexpr size_t WS_R = 197 * MiB;
constexpr size_t WS_GB = 229 * MiB;
constexpr size_t WS_HID = 149 * MiB;
constexpr size_t WS_END = 261 * MiB;
static_assert(WS_HID + (size_t)M * FF * 2 <= WS_END && WS_WDN + (size_t)D * FF * 2 <= WS_PWT && WS_WGU + (size_t)2 * FF * D * 2 <= WS_WDN, "d_ws map");
constexpr int MISC_OFF = 147392;
constexpr int LDS_BYTES = 147456;

typedef unsigned short bf16;
typedef pg8::f32x4 f32x4;
typedef pg8::u32x4 u32x4;
typedef pg8::u32x2 u32x2;
typedef pg8::bf16x8 bf16x8;
using pg8::cvt_pk_bf16; using pg8::bf_lo; using pg8::bf_hi; using pg8::pack8; using pg8::unpack8; using pg8::ld_agent;

struct Args { const float* in[18]; float* out; unsigned char* ws; };
struct Frame {
    LAS unsigned char* lds; int tid, lane, wave, G, bid;
    const float *x, *norm1_pre, *w_in, *v_ln_g, *v_ln_b, *sgu_w, *sgu_b, *pool_w, *pool_scale, *w_a, *w_b, *w_out, *norm1_post, *norm2_pre, *w_gate, *w_up, *w_down, *norm2_post;
    float* out; float *vsum, *vsq, *st1, *st2, *st3;
    bf16 *WIN, *WAB, *WOUT, *WGU, *WDN, *PWT, *SGW, *XN, *XG, *YA, *YB, *UV, *MG, *P, *R, *GB, *HID;
};
__device__ __forceinline__ float wave_sum(float v) {
#pragma unroll
    for (int o = 1; o < 64; o <<= 1) v += __shfl_xor(v, o);
    return v;
}
struct TItem { const float* src; bf16* dst; const float* ks; int N, ldo, mode, pad; };
__device__ __forceinline__ TItem mk_item(const float* W, int N, int k0, int n0, bf16* WT, int ldo, int orow0, const float* kscale = nullptr, int mode = 0) {
    TItem t; t.mode = mode; t.pad = 0; t.src = W + (size_t)k0 * N + n0; t.dst = WT + (size_t)orow0 * ldo + k0; t.ks = kscale ? kscale + k0 : nullptr; t.N = N; t.ldo = ldo; return t; }
__device__ __forceinline__ void titem_load(const TItem& t, f32x4 (&v)[16], int lane) {
    const int lr = lane >> 4, lc = 4 * (lane & 15);
#pragma unroll
    for (int i = 0; i < 16; ++i) v[i] = __builtin_nontemporal_load((const f32x4*)(t.src + (size_t)(4 * i + lr) * t.N + lc));
}
template <bool NT>
__device__ __forceinline__ void titem_finish(const TItem& t, const f32x4 (&v)[16], LAS float* scr, int lane) {
    const int lr = lane >> 4, lc = 4 * (lane & 15);
#pragma unroll
    for (int i = 0; i < 16; ++i) { const int kk = 4 * i + lr; scr[kk * 65 + lc + 0] = v[i][0]; scr[kk * 65 + lc + 1] = v[i][1]; scr[kk * 65 + lc + 2] = v[i][2]; scr[kk * 65 + lc + 3] = v[i][3]; }
    asm volatile("s_waitcnt lgkmcnt(0)" ::: "memory");
    const int c = lane & 7;
    f32x4 ks0 = (f32x4){1.f, 1.f, 1.f, 1.f}, ks1 = ks0;
    if (t.ks) { ks0 = *(const f32x4*)(t.ks + 8 * c); ks1 = *(const f32x4*)(t.ks + 8 * c + 4); }
#pragma unroll
    for (int jj = 0; jj < 8; ++jj) { const int n = 8 * jj + (lane >> 3); const LAS float* s = scr + (8 * c) * 65 + n;
        u32x4 o; o.x = cvt_pk_bf16(s[0 * 65] * ks0[0], s[1 * 65] * ks0[1]); o.y = cvt_pk_bf16(s[2 * 65] * ks0[2], s[3 * 65] * ks0[3]); o.z = cvt_pk_bf16(s[4 * 65] * ks1[0], s[5 * 65] * ks1[1]); o.w = cvt_pk_bf16(s[6 * 65] * ks1[2], s[7 * 65] * ks1[3]);
        if (t.mode == 2) st16_wt(t.dst + (size_t)n * t.ldo + 8 * c, o); else if (NT) __builtin_nontemporal_store(o, (u32x4*)(t.dst + (size_t)n * t.ldo + 8 * c)); else *(u32x4*)(t.dst + (size_t)n * t.ldo + 8 * c) = o; }
    asm volatile("s_waitcnt lgkmcnt(0)" ::: "memory");
}
constexpr int I_IN = (D / 64) * (DIN / 64), I_A = (DS / 64) * (D / 64), I_OUT = (D / 64) * (D / 64), I_G = (D / 64) * (FF / 64), I_D = (FF / 64) * (D / 64), I_PW = 4 * 16;
__device__ __forceinline__ int win_orow(int n0) { if (n0 < 3072) return n0; const int q = n0 - 3072, isb = q / D, c = q % D; return 3072 + (c / 128) * 256 + isb * 128 + (c % 128); }
constexpr int I_INH = 32 * 56;
template <int SET>
__device__ __forceinline__ TItem decode_item(const Frame& F, int r) {
    if constexpr (SET == 0) {
        if (r < I_INH) { const int e = r % 56, k0 = 64 * (r / 56), n0 = 64 * (e < 28 ? e : (e < 42 ? 24 + e : 42 + e)); return mk_item(F.w_in, DIN, k0, n0, F.WIN, D, win_orow(n0)); } r -= I_INH;
        const int g = r / 16, rr = r % 16; return mk_item(F.pool_w + (size_t)g * 65536, 256, 64 * (rr / 4), 64 * (rr % 4), F.PWT + (size_t)g * 65536, 256, 64 * (rr % 4));
    } else if constexpr (SET == 3) {
        const int l = r % 56, k0 = 64 * (r / 56), n0 = 64 * (l < 24 ? 28 + l : (l < 42 ? 42 + l : 56 + l));
        return mk_item(F.w_in, DIN, k0, n0, F.WIN, D, win_orow(n0), nullptr, 2);
    } else if constexpr (SET == 1) {
        if (r < I_A) { const int nblk = D / 64; return mk_item(F.w_a, D, 64 * (r / nblk), 64 * (r % nblk), F.WAB, DS, 64 * (r % nblk)); } r -= I_A;
        if (r < I_A) { const int nblk = D / 64; return mk_item(F.w_b, D, 64 * (r / nblk), 64 * (r % nblk), F.WAB + (size_t)D * DS, DS, 64 * (r % nblk)); } r -= I_A;
        if (r < I_OUT) { const int nblk = D / 64; return mk_item(F.w_out, D, 64 * (r / nblk), 64 * (r % nblk), F.WOUT, D, 64 * (r % nblk)); } r -= I_OUT;
        if (r < I_G) { const int nblk = FF / 64, n0 = 64 * (r % nblk); return mk_item(F.w_gate, FF, 64 * (r / nblk), n0, F.WGU, D, (n0 / 128) * 256 + (n0 % 128), F.norm2_pre); } r -= I_G;
        const int nblk = FF / 64, n0 = 64 * (r % nblk); return mk_item(F.w_up, FF, 64 * (r / nblk), n0, F.WGU, D, (n0 / 128) * 256 + 128 + (n0 % 128), F.norm2_pre);
    } else {
        const int nblk = D / 64; return mk_item(F.w_down, D, 64 * (r / nblk), 64 * (r % nblk), F.WDN, FF, 64 * (r % nblk));
    }
}
template <int SET>
__device__ __forceinline__ void convert_weights(const Frame& F, int gw, int NGW) {
    LAS float* scr = (LAS float*)(F.lds + F.wave * 16640);
    constexpr int NITEMS = SET == 0 ? I_INH + I_PW : (SET == 1 ? 2 * I_A + I_OUT + 2 * I_G : (SET == 3 ? I_INH : I_D));
    int it = gw; if (it >= NITEMS) return;
    TItem cur = decode_item<SET>(F, it); f32x4 v[16]; titem_load(cur, v, F.lane);
    for (;;) {
        const int nit = it + NGW; const bool hn = nit < NITEMS;
        TItem nx = cur; f32x4 nv[16];
        if (hn) { nx = decode_item<SET>(F, nit); titem_load(nx, nv, F.lane); }
        titem_finish<SET == 1>(cur, v, scr, F.lane);
        if (!hn) break;
        cur = nx; it = nit;
#pragma unroll
        for (int i = 0; i < 16; ++i) v[i] = nv[i];
    }
}
__device__ __forceinline__ void p0_prologue(const Frame& F) {
    const int gw = F.bid * NWAVES + F.wave, NGW = F.G * NWAVES;
    for (int i = F.bid * NTHREADS + F.tid; i < 5 * M; i += F.G * NTHREADS) F.vsum[i] = 0.f;
    for (int i = (F.bid * NTHREADS + F.tid) * 8; i < 8 * 128 * 128; i += F.G * NTHREADS * 8) {
        const f32x4 a = *(const f32x4*)(F.sgu_w + i), b = *(const f32x4*)(F.sgu_w + i + 4); *(u32x4*)(F.SGW + i) = pack8(a, b); }
    {
        const f32x4* gr = (const f32x4*)F.norm1_pre + F.lane;
        int m = gw; f32x4 v[8];
        if (m < M) { const f32x4* xr = (const f32x4*)(F.x + (size_t)m * D) + F.lane;
#pragma unroll
            for (int j = 0; j < 8; ++j) v[j] = xr[64 * j]; }
        while (m < M) {
            const int nm = m + NGW; f32x4 nv[8];
            if (nm < M) { const f32x4* xr = (const f32x4*)(F.x + (size_t)nm * D) + F.lane;
#pragma unroll
                for (int j = 0; j < 8; ++j) nv[j] = xr[64 * j]; }
            float s = 0.f;
#pragma unroll
            for (int j = 0; j < 8; ++j) s += (v[j][0] * v[j][0] + v[j][1] * v[j][1]) + (v[j][2] * v[j][2] + v[j][3] * v[j][3]);
            const float rs = __builtin_amdgcn_rsqf(wave_sum(s) * (1.f / D) + EPS);
            u32x2* o = (u32x2*)(F.XN + (size_t)m * D) + F.lane;
#pragma unroll
            for (int j = 0; j < 8; ++j) { const f32x4 t = v[j] * rs * gr[64 * j]; u32x2 w; w.x = cvt_pk_bf16(t[0], t[1]); w.y = cvt_pk_bf16(t[2], t[3]); o[64 * j] = w; }
            if (nm < M) {
#pragma unroll
                for (int j = 0; j < 8; ++j) v[j] = nv[j]; }
            m = nm;
        }
    }
    convert_weights<0>(F, gw, NGW);
}
constexpr int VS = 136, PS = 264;
__device__ __forceinline__ void sgu_unit(const Frame& F, int nb, int h) {
    LAS bf16* Vt = (LAS bf16*)F.lds;
    const int lane = F.lane, w = F.wave, fr = lane & 15, fq = lane >> 4, t0 = nb * 128;
    const int nks = (w < 4) ? 2 : 4;
    bf16x8 Af[4];
#pragma unroll
    for (int ks = 0; ks < 4; ++ks) Af[ks] = *(const bf16x8*)(F.SGW + ((size_t)(h * 128 + 16 * w + fr) * 128 + (ks < nks ? ks : 0) * 32 + 8 * fq));
#pragma unroll
    for (int it = 0; it < 2; ++it) {
        const int idx = F.tid + NTHREADS * it, chunk = idx & 15, j = 2 * (idx >> 4);
        const bf16* src = F.UV + (size_t)(t0 + j) * D + DS + h * 128 + 8 * chunk;
        f32x4 a0, a1, b0, b1; unpack8(*(const u32x4*)src, a0, a1); unpack8(*(const u32x4*)(src + D), b0, b1);
        const float mu0 = ld_agent(F.vsum + t0 + j) * (1.f / DS), mu1 = ld_agent(F.vsum + t0 + j + 1) * (1.f / DS);
        const float rs0 = __builtin_amdgcn_rsqf(fmaxf(ld_agent(F.vsq + t0 + j) * (1.f / DS) - mu0 * mu0, 0.f) + EPS), rs1 = __builtin_amdgcn_rsqf(fmaxf(ld_agent(F.vsq + t0 + j + 1) * (1.f / DS) - mu1 * mu1, 0.f) + EPS);
        const f32x4 g0 = *(const f32x4*)(F.v_ln_g + h * 128 + 8 * chunk), g1 = *(const f32x4*)(F.v_ln_g + h * 128 + 8 * chunk + 4);
        const f32x4 c0 = *(const f32x4*)(F.v_ln_b + h * 128 + 8 * chunk), c1 = *(const f32x4*)(F.v_ln_b + h * 128 + 8 * chunk + 4);
        const f32x4 y00 = (a0 - mu0) * rs0 * g0 + c0, y01 = (a1 - mu0) * rs0 * g1 + c1, y10 = (b0 - mu1) * rs1 * g0 + c0, y11 = (b1 - mu1) * rs1 * g1 + c1;
#pragma unroll
        for (int q = 0; q < 4; ++q) { *(LAS unsigned*)(Vt + (8 * chunk + q) * VS + j) = cvt_pk_bf16(y00[q], y10[q]); *(LAS unsigned*)(Vt + (8 * chunk + 4 + q) * VS + j) = cvt_pk_bf16(y01[q], y11[q]); }
    }
    __syncthreads();
    f32x4 acc[8];
#pragma unroll
    for (int nt = 0; nt < 8; ++nt) acc[nt] = (f32x4){0.f, 0.f, 0.f, 0.f};
#pragma unroll
    for (int ks = 0; ks < 4; ++ks) if (ks < nks) {
#pragma unroll
        for (int nt = 0; nt < 8; ++nt) { const bf16x8 Bf = *(const LAS bf16x8*)(Vt + (16 * nt + fr) * VS + 32 * ks + 8 * fq); acc[nt] = __builtin_amdgcn_mfma_f32_16x16x32_bf16(Bf, Af[ks], acc[nt], 0, 0, 0); } }
    const int i = 16 * w + fr; const float bias = F.sgu_b[h * 128 + i];
    LAS unsigned char* ost = F.lds + 36864 + w * 4352;
#pragma unroll
    for (int nt = 0; nt < 8; ++nt) { const int c = h * 128 + 16 * nt + 4 * fq; const u32x2 uu = *(const u32x2*)(F.UV + (size_t)(t0 + i) * D + c);
        u32x2 o; o.x = cvt_pk_bf16(bf_lo(uu.x) * (acc[nt][0] + bias), bf_hi(uu.x) * (acc[nt][1] + bias)); o.y = cvt_pk_bf16(bf_lo(uu.y) * (acc[nt][2] + bias), bf_hi(uu.y) * (acc[nt][3] + bias));
        *(LAS u32x2*)(ost + fr * 272 + (16 * nt + 4 * fq) * 2) = o; }
    asm volatile("s_waitcnt lgkmcnt(0)" ::: "memory");
#pragma unroll
    for (int k = 0; k < 4; ++k) { const int q = lane + 64 * k, row = q >> 4, ch = q & 15;
        st16_wt(F.YA + (size_t)(t0 + 16 * w + row) * DS + h * 128 + 8 * ch, *(const LAS u32x4*)(ost + row * 272 + ch * 16)); }
    __syncthreads();
}
template <int WIN>
__device__ __forceinline__ void pool_stage(const Frame& F, LAS bf16* Ap, int t0, int g) {
    const int chunk = F.tid & 31, tb = 8 * (F.tid >> 5), pos0 = (t0 & (SEQ - 1)) + tb;
    const bf16* src = F.P + (size_t)(t0 + tb) * DP + g * 256 + 8 * chunk;
    constexpr int NR = 8 + WIN - 1;
    u32x4 raw[NR];
#pragma unroll
    for (int r = 0; r < NR; ++r) { const int d = r - (WIN - 1);
        raw[r] = (pos0 + d >= 0) ? *(const u32x4*)(src + (ptrdiff_t)d * DP) : (u32x4){0u, 0u, 0u, 0u}; }
    f32x4 s0 = (f32x4){0.f, 0.f, 0.f, 0.f}, s1 = s0;
#pragma unroll
    for (int r = 0; r < WIN - 1; ++r) { f32x4 a, b; unpack8(raw[r], a, b); s0 += a; s1 += b; }
#pragma unroll
    for (int i = 0; i < 8; ++i) { f32x4 a, b; unpack8(raw[WIN - 1 + i], a, b); s0 += a; s1 += b;
        const int pos = pos0 + i; const float inv = 1.f / (float)((pos + 1 < WIN) ? pos + 1 : WIN);
        *(LAS u32x4*)(Ap + (tb + i) * PS + 8 * chunk) = pack8(s0 * inv - a, s1 * inv - b);
        f32x4 c, d; unpack8(raw[i], c, d); s0 -= c; s1 -= d; }
}
__device__ __forceinline__ void pool_unit(const Frame& F, int nb, int g) {
    LAS bf16* Ap = (LAS bf16*)F.lds;
    LAS unsigned char* Bs = F.lds + 67584;
    const int lane = F.lane, w = F.wave, fr = lane & 15, fq = lane >> 4, t0 = nb * 128;
    const bf16* Bsrc = F.PWT + (size_t)g * 65536 + (size_t)(F.tid >> 4) * 256 + 8 * (F.tid & 15);
    u32x4 breg[8];
#pragma unroll
    for (int i = 0; i < 8; ++i) breg[i] = *(const u32x4*)(Bsrc + (size_t)(32 * i) * 256);
    switch (g) { case 0: pool_stage<2>(F, Ap, t0, g); break; case 1: pool_stage<4>(F, Ap, t0, g); break; case 2: pool_stage<8>(F, Ap, t0, g); break; default: pool_stage<16>(F, Ap, t0, g); break; }
#pragma unroll
    for (int i = 0; i < 8; ++i) *(LAS u32x4*)(Bs + ((F.tid >> 4) + 32 * i) * 272 + (F.tid & 15) * 16) = breg[i];
    __syncthreads();
#pragma unroll
    for (int i = 0; i < 8; ++i) breg[i] = *(const u32x4*)(Bsrc + (size_t)(32 * i) * 256 + 128);
    const int wm = w >> 2, wn = w & 3;
    f32x4 acc[4][4];
#pragma unroll
    for (int a = 0; a < 4; ++a)
#pragma unroll
        for (int b = 0; b < 4; ++b) acc[a][b] = (f32x4){0.f, 0.f, 0.f, 0.f};
#pragma unroll
    for (int h = 0; h < 2; ++h) {
#pragma unroll
        for (int ks = 0; ks < 4; ++ks) {
            bf16x8 Af[4], Bf[4];
#pragma unroll
            for (int ni = 0; ni < 4; ++ni) Bf[ni] = *(const LAS bf16x8*)(Bs + (64 * wn + 16 * ni + fr) * 272 + (32 * ks + 8 * fq) * 2);
#pragma unroll
            for (int mi = 0; mi < 4; ++mi) Af[mi] = *(const LAS bf16x8*)(Ap + (64 * wm + 16 * mi + fr) * PS + 128 * h + 32 * ks + 8 * fq);
#pragma unroll
            for (int mi = 0; mi < 4; ++mi)
#pragma unroll
                for (int ni = 0; ni < 4; ++ni) acc[mi][ni] = __builtin_amdgcn_mfma_f32_16x16x32_bf16(Bf[ni], Af[mi], acc[mi][ni], 0, 0, 0);
        }
        __syncthreads();
        if (h == 0) {
#pragma unroll
            for (int i = 0; i < 8; ++i) *(LAS u32x4*)(Bs + ((F.tid >> 4) + 32 * i) * 272 + (F.tid & 15) * 16) = breg[i];
            __syncthreads(); }
    }
    LAS unsigned char* ost = F.lds + 67584 + w * 8704;
#pragma unroll
    for (int ni = 0; ni < 4; ++ni) { const int d = g * 256 + 64 * wn + 16 * ni + 4 * fq; const f32x4 sc = *(const f32x4*)(F.pool_scale + d);
#pragma unroll
        for (int mi = 0; mi < 4; ++mi) { const f32x4 o = acc[mi][ni] * sc; u32x2 wv; wv.x = cvt_pk_bf16(o[0], o[1]); wv.y = cvt_pk_bf16(o[2], o[3]);
            *(LAS u32x2*)(ost + (16 * mi + fr) * 136 + (16 * ni + 4 * fq) * 2) = wv; } }
    asm volatile("s_waitcnt lgkmcnt(0)" ::: "memory");
#pragma unroll
    for (int k = 0; k < 8; ++k) { const int q = lane + 64 * k, row = q >> 3, ch = q & 7;
        const LAS unsigned* p = (const LAS unsigned*)(ost + row * 136 + ch * 16);
        st16_wt(F.YB + (size_t)(t0 + 64 * wm + row) * DP + g * 256 + 64 * wn + 8 * ch, (u32x4){p[0], p[1], p[2], p[3]}); }
    __syncthreads();
}

__global__ void __launch_bounds__(NTHREADS, 2) mega_fwd(Args args) {
    extern __shared__ __attribute__((aligned(16))) unsigned char lds_raw[];
    cg::grid_group grid = cg::this_grid();
    Frame F;
    F.lds = (LAS unsigned char*)lds_raw; F.tid = threadIdx.x; F.lane = F.tid & 63; F.wave = __builtin_amdgcn_readfirstlane(F.tid >> 6); F.G = gridDim.x; F.bid = blockIdx.x;
    F.x = args.in[0]; F.norm1_pre = args.in[1]; F.w_in = args.in[2]; F.v_ln_g = args.in[3]; F.v_ln_b = args.in[4]; F.sgu_w = args.in[5]; F.sgu_b = args.in[6]; F.pool_w = args.in[7]; F.pool_scale = args.in[8];
    F.w_a = args.in[9]; F.w_b = args.in[10]; F.w_out = args.in[11]; F.norm1_post = args.in[12]; F.norm2_pre = args.in[13]; F.w_gate = args.in[14]; F.w_up = args.in[15]; F.w_down = args.in[16]; F.norm2_post = args.in[17];
    F.out = args.out; unsigned char* ws = args.ws;
    F.vsum = (float*)(ws + WS_STAT); F.vsq = F.vsum + M; F.st1 = F.vsum + 2 * M; F.st2 = F.vsum + 3 * M; F.st3 = F.vsum + 4 * M;
    F.WIN = (bf16*)(ws + WS_WIN); F.WAB = (bf16*)(ws + WS_WAB); F.WOUT = (bf16*)(ws + WS_WOUT); F.WGU = (bf16*)(ws + WS_WGU); F.WDN = (bf16*)(ws + WS_WDN); F.PWT = (bf16*)(ws + WS_PWT); F.SGW = (bf16*)(ws + WS_SGW);
    F.XN = (bf16*)(ws + WS_XN); F.XG = (bf16*)(ws + WS_XG); F.YA = F.XN; F.YB = F.XN + (size_t)M * DS; F.UV = (bf16*)(ws + WS_UV); F.MG = (bf16*)(ws + WS_XG);     F.P = (bf16*)(ws + WS_P); F.R = (bf16*)(ws + WS_R); F.GB = (bf16*)(ws + WS_GB); F.HID = (bf16*)(ws + WS_HID);

    if (F.tid < 16) ((LAS unsigned*)(F.lds + MISC_OFF))[F.tid] = 0u;
    __syncthreads();
    const XcdBarrier bar = xcd_barrier_post((unsigned*)(ws + WS_BAR), (volatile LAS unsigned*)(F.lds + MISC_OFF));
    if (args.out == nullptr) grid.sync();
    p0_prologue(F);
    if (PROBE_REP == 0) p0_prologue(F);
    if (PROBE_REP == 8) { for (int i = 0; i < 8; ++i) { xcd_barrier(bar); } }
    xcd_barrier(bar);
    constexpr int G1 = 224;
    unsigned* const tmo0 = (unsigned*)(ws + WS_BAR) + XB_TMO;
    unsigned* const lateW = (unsigned*)(ws + WS_BAR) + 30720;
    if (F.bid < G1) { pg8::Gemm g{F.XN, F.XN, F.WIN, F.WIN, M, DIN, D}; pg8::RangeOrder S; S.so.init(M, DIN, G1, F.bid);
      pg8::EpiIn E{F.UV, F.P, F.R, F.GB, F.vsum, F.vsq};
      S.base = 0; S.count = 2; pg8::gemm_phase<pg8::EpiIn, pg8::RangeOrder, true, true>(F.lds, g, S, E);
      if (F.tid == 0) { unsigned sp = 0; while (xb_ld(lateW) < (unsigned)((F.G - G1) * NWAVES)) { __builtin_amdgcn_s_sleep(1); if ((++sp & 255u) == 0u) { if (xb_ld(tmo0)) break; if (sp > XB_SPIN_CAP) { atomicAdd(tmo0, 1u); break; } } } }
      __syncthreads();
      S.base = 2; S.count = 2; pg8::gemm_phase<pg8::EpiIn, pg8::RangeOrder, true, true>(F.lds, g, S, E); }
    else { const int cw = (F.bid - G1) * NWAVES + F.wave, ncw = (F.G - G1) * NWAVES;
      convert_weights<3>(F, cw, ncw);
      asm volatile("s_waitcnt vmcnt(0)" ::: "memory"); if (F.lane == 0) (void)xb_add(lateW, 1u);
      convert_weights<1>(F, cw, ncw); }
    xcd_barrier(bar);
    pg8::Unit u0; { pg8::StaticOrder S0; S0.init(M, D, F.G, F.bid); S0.next(0, u0); }
    unsigned* const pwords = (unsigned*)(ws + WS_BAR) + PW_BASE + u0.pm * 64; unsigned* const tmo = (unsigned*)(ws + WS_BAR) + XB_TMO;
    for (int rep = 0; rep < (PROBE_REP == 2 ? 2 : 1); ++rep) {
        pool_unit(F, 2 * u0.pm + (u0.pn >> 2), u0.pn & 3);
        sgu_unit(F, 2 * u0.pm + (u0.pn >> 2), 2 * (u0.pn & 3)); sgu_unit(F, 2 * u0.pm + (u0.pn >> 2), 2 * (u0.pn & 3) + 1); }
    panel_barrier<false>(pwords + 0 * PW_SEAM, tmo);
    { pg8::Gemm g{F.YA, F.YB, F.WAB, F.WAB + (size_t)D * DS, M, D, DS}; pg8::PairOrder S; S.so.init(M, D, F.G, F.bid);
      pg8::EpiMerge E{F.R, F.GB, F.MG};
      if (PROBE_REP == 3) pg8::gemm_phase<pg8::EpiMerge, pg8::PairOrder, true, true>(F.lds, g, S, E);
      pg8::gemm_phase<pg8::EpiMerge, pg8::PairOrder, true, true>(F.lds, g, S, E); }
    panel_barrier<false>(pwords + 1 * PW_SEAM, tmo);
    { pg8::Gemm g{F.MG, F.MG, F.WOUT, F.WOUT, M, D, D}; pg8::StaticOrder S; S.init(M, D, F.G, F.bid);
      pg8::EpiNorm1 E{F.x, F.XG, F.norm1_post, F.st1, F.st2, pwords + 2 * PW_SEAM, tmo};
      if (PROBE_REP == 4) { pg8::EpiNull E0{(float*)(ws + WS_BAR + 131072)}; pg8::gemm_phase<pg8::EpiNull, pg8::StaticOrder, false, true>(F.lds, g, S, E0); }
      pg8::gemm_phase<pg8::EpiNorm1, pg8::StaticOrder, false, true>(F.lds, g, S, E); }
    xcd_barrier(bar);
    { pg8::Gemm g{F.XG, F.XG, F.WGU, F.WGU, M, 2 * FF, D}; pg8::IdxOrder S; S.so.init(M, 2 * FF, F.G, F.bid);
      LAS float* rsT = (LAS float*)(F.lds + 131072);
      if (F.tid < 256) { pg8::Unit uu; for (int i = 0; i < 8 && S.next(i, uu); ++i) rsT[i * 256 + F.tid] = __builtin_amdgcn_rsqf(F.st2[uu.pm * 256 + F.tid] * (1.f / D) + EPS); }
      __syncthreads();
      pg8::EpiSwiGLU E{F.HID, rsT};
      pg8::gemm_phase<pg8::EpiSwiGLU, pg8::IdxOrder, true, true>(F.lds, g, S, E); }
    { constexpr int U6 = (M / 256) * (2 * FF / 256), TAIL0 = U6 % 256;
      if (TAIL0 != 0 && F.bid >= TAIL0) convert_weights<2>(F, (F.bid - TAIL0) * NWAVES + F.wave, (F.G - TAIL0) * NWAVES);
      else if (TAIL0 == 0) convert_weights<2>(F, F.bid * NWAVES + F.wave, F.G * NWAVES); }
    xcd_barrier(bar);
    { pg8::Gemm g{F.HID, F.HID, F.WDN, F.WDN, M, D, FF}; pg8::StaticOrder S; S.init(M, D, F.G, F.bid);
      pg8::EpiNorm2 E{F.out, F.XG, F.norm2_post, F.st3, pwords + 3 * PW_SEAM, tmo};
      if (PROBE_REP == 7) { pg8::EpiNull E0{(float*)(ws + WS_BAR + 131072)}; pg8::gemm_phase<pg8::EpiNull, pg8::StaticOrder, false, true>(F.lds, g, S, E0); }
      pg8::gemm_phase<pg8::EpiNorm2, pg8::StaticOrder, false, true>(F.lds, g, S, E); }
}

extern "C" void kernel_launch(void* const* d_in, const int* in_sizes, int n_in, void* d_out, int out_size, void* d_ws, size_t ws_size, hipStream_t stream) {
    static int grid = 0;
    if (grid == 0) {
        if (n_in != 18 || in_sizes[0] != M * D || out_size != M * D || ws_size < WS_END) { fprintf(stderr, "kernel_launch: unexpected shapes (n_in %d, in0 %d, out %d, ws %zu); nothing launched\n", n_in, n_in > 0 ? in_sizes[0] : -1, out_size, ws_size); grid = -1; return; }
        int dev = 0, cus = 0, per_cu = 0;
        if (hipGetDevice(&dev) != hipSuccess || hipDeviceGetAttribute(&cus, hipDeviceAttributeMultiprocessorCount, dev) != hipSuccess) { grid = -1; return; }
        if (hipFuncSetAttribute((const void*)mega_fwd, hipFuncAttributeMaxDynamicSharedMemorySize, LDS_BYTES) != hipSuccess) { fprintf(stderr, "kernel_launch: hipFuncSetAttribute failed\n"); grid = -1; return; }
        if (hipOccupancyMaxActiveBlocksPerMultiprocessor(&per_cu, (const void*)mega_fwd, NTHREADS, LDS_BYTES) != hipSuccess || per_cu < 1) { fprintf(stderr, "kernel_launch: occupancy query reports %d blocks per CU\n", per_cu); (void)hipGetLastError(); grid = -1; return; }
        if (cus * per_cu < 256) { fprintf(stderr, "kernel_launch: needs 256 co-resident workgroups, device holds %d\n", cus * per_cu); grid = -1; return; }
        grid = 256;
    }
    if (grid < 0) return;
    Args a{};
    for (int i = 0; i < 18; ++i) a.in[i] = (const float*)d_in[i];
    a.out = (float*)d_out; a.ws = (unsigned char*)d_ws;
    if (hipMemsetAsync((char*)d_ws + WS_BAR, 0, 65536, stream) != hipSuccess) { fprintf(stderr, "kernel_launch: memset failed\n"); return; }
    void* kargs[] = {&a};
    hipError_t e = hipLaunchCooperativeKernel((const void*)mega_fwd, dim3(grid), dim3(NTHREADS), kargs, LDS_BYTES, stream);
    if (e != hipSuccess) fprintf(stderr, "kernel_launch: cooperative launch failed: %s\n", hipGetErrorString(e));
}
```

```cpp
#ifndef PROBE_REP
#define PROBE_REP -1
#endif
#include <hip/hip_runtime.h>
#include <hip/hip_cooperative_groups.h>
#include <cstdio>
#include <cstdint>
namespace cg = cooperative_groups;
#define LAS __attribute__((address_space(3)))
#define XB_TMO      128
#define XB_XCNT(j)  (256  + 64 * (j))
#define XB_XSUB(j)  (1280 + 64 * (j))
#define XB_XGEN(j)  (2304 + 64 * (j))
#define XB_TOP      3328
#define XB_TOPGEN   3392
#define XCD_BAR_WORDS 3456
#define XB_SPIN_CAP (1u << 18)

__device__ __forceinline__ unsigned xb_ld(unsigned* p)              { return __hip_atomic_load(p, __ATOMIC_RELAXED, __HIP_MEMORY_SCOPE_AGENT); }
__device__ __forceinline__ unsigned xb_add(unsigned* p, unsigned v) { return __hip_atomic_fetch_add(p, v, __ATOMIC_RELAXED, __HIP_MEMORY_SCOPE_AGENT); }
__device__ __forceinline__ unsigned xb_xcc_id() { return (unsigned)__builtin_amdgcn_s_getreg((3 << 11) | 20) & 0xFu; }
#define XB_SPIN(cond, bar) do { unsigned _sp = 0; while (cond) { __builtin_amdgcn_s_sleep(1); \
    if ((++_sp & 255u) == 0u) { if (xb_ld(&(bar)[XB_TMO])) break; if (_sp > XB_SPIN_CAP) { atomicAdd(&(bar)[XB_TMO], 1u); break; } } } } while (0)

struct XcdBarrier {
    unsigned* bar; unsigned x;
    volatile LAS unsigned* st;
};

__device__ __forceinline__ XcdBarrier xcd_barrier_post(unsigned* bar, volatile LAS unsigned* st) {
    XcdBarrier b; b.bar = bar; b.x = xb_xcc_id(); b.st = st;
    if (threadIdx.x == 0) (void)xb_add(&bar[XB_XCNT(b.x)], 1u);
    return b;
}
__device__ __forceinline__ void xcd_barrier_complete(unsigned* bar, unsigned x, unsigned& nloc, unsigned& nx) {
    const unsigned G = gridDim.x * gridDim.y * gridDim.z;
    unsigned sum, cnt, mine, sp = 0u;
    for (;;) {
        sum = 0u; cnt = 0u; mine = 0u;
#pragma unroll
        for (unsigned j = 0; j < 16; ++j) { const unsigned c = xb_ld(&bar[XB_XCNT(j)]); sum += c; cnt += (c > 0u) ? 1u : 0u; mine = (j == x) ? c : mine; }
        if (sum == G) break;
        __builtin_amdgcn_s_sleep(1);
        if ((++sp & 255u) == 0u) { if (xb_ld(&bar[XB_TMO])) break; if (sp > XB_SPIN_CAP) { atomicAdd(&bar[XB_TMO], 1u); break; } }
    }
    nloc = mine > 0u ? mine : 1u; nx = cnt > 0u ? cnt : 1u;
}

__device__ __forceinline__ void xcd_barrier(const XcdBarrier& b) {
    asm volatile("s_waitcnt vmcnt(0)" ::: "memory");
    __syncthreads();
    if (threadIdx.x == 0) {
        unsigned* bar = b.bar;
        __builtin_amdgcn_s_waitcnt(0);
        unsigned nloc = b.st[0], nx = b.st[1];
        if (nloc == 0u) { xcd_barrier_complete(bar, b.x, nloc, nx); b.st[0] = nloc; b.st[1] = nx; }
        const unsigned old = xb_add(&bar[XB_XSUB(b.x)], 1u);
        const unsigned gen = old / nloc;
        if (old + 1u == (gen + 1u) * nloc) {
            __builtin_amdgcn_fence(__ATOMIC_RELEASE, "agent");
            asm volatile("s_waitcnt vmcnt(0)" ::: "memory");
            const unsigned og = xb_add(&bar[XB_TOP], 1u);
            const unsigned tg = og / nx;
            if (og + 1u == (tg + 1u) * nx) xb_add(&bar[XB_TOPGEN], 1u);
            else XB_SPIN(xb_ld(&bar[XB_TOPGEN]) == tg, bar);
            __builtin_amdgcn_fence(__ATOMIC_ACQUIRE, "agent");
            xb_add(&bar[XB_XGEN(b.x)], 1u);
            asm volatile("s_waitcnt vmcnt(0)" ::: "memory");
        } else {
            XB_SPIN(xb_ld(&bar[XB_XGEN(b.x)]) == gen, bar);
            __builtin_amdgcn_fence(__ATOMIC_ACQUIRE, "agent");
            asm volatile("s_waitcnt vmcnt(0)" ::: "memory");
        }
    }
    __syncthreads();
}


template <bool ACQ>
__device__ __forceinline__ void panel_barrier(unsigned* word, unsigned* tmo) {
    asm volatile("s_waitcnt vmcnt(0)" ::: "memory");
    __syncthreads();
    if (threadIdx.x == 0) {
        (void)xb_add(word, 1u);
        unsigned sp = 0;
        while (xb_ld(word) < 8u) { __builtin_amdgcn_s_sleep(1); if ((++sp & 255u) == 0u) { if (xb_ld(tmo)) break; if (sp > XB_SPIN_CAP) { atomicAdd(tmo, 1u); break; } } }
        if (ACQ) { __builtin_amdgcn_fence(__ATOMIC_ACQUIRE, "agent"); asm volatile("s_waitcnt vmcnt(0)" ::: "memory"); }
    }
    __syncthreads();
}
typedef unsigned wt_u32x4 __attribute__((ext_vector_type(4)));
typedef unsigned wt_u32x2 __attribute__((ext_vector_type(2)));
__device__ __forceinline__ void st16_wt(void* p, wt_u32x4 v) { asm volatile("global_store_dwordx4 %0, %1, off sc1\n\ts_nop 1" : : "v"(p), "v"(v) : "memory"); }
__device__ __forceinline__ void st8_wt(void* p, wt_u32x2 v) { asm volatile("global_store_dwordx2 %0, %1, off sc1" : : "v"(p), "v"(v) : "memory"); }
namespace pg8 {
#define PG8_LAS __attribute__((address_space(3)))
typedef unsigned short bf16_t;
typedef short bf16x8 __attribute__((ext_vector_type(8)));
typedef float f32x4 __attribute__((ext_vector_type(4)));
typedef unsigned u32x4 __attribute__((ext_vector_type(4)));
constexpr int BM = 256, BK = 64, HALF = 128, HTB = HALF * BK * 2  , STAGE_BYTES = 8 * HTB, NXCD = 8, WGM = 8;

__host__ __device__ __forceinline__ int lds_byte(int r, int c) { const int st = (r >> 4) * 2 + (c >> 5), rr = r & 15, cc = c & 31, ob = rr * 64 + cc * 2; return st * 1024 + (ob ^ (((ob >> 9) & 1) << 5)); }
__host__ __device__ __forceinline__ void stage_rc(int b, int& R, int& C) { const int st = b / 1024, sb = b % 1024, swz = sb ^ (((sb >> 9) & 1) << 5); R = (st >> 1) * 16 + swz / 64; C = (st & 1) * 32 + (swz % 64) / 2; }
__host__ __device__ __forceinline__ int perm32(int rho) { const int n = rho >> 4, i = rho & 15; return 8 * (i >> 2) + 4 * n + (i & 3); }

struct Unit { int pm, pn, z; };
struct Gemm { const bf16_t *A0, *A1, *B0, *B1; int M, N, K; };

struct StaticOrder {
    int nM, nN, nwg, G, c;
    __host__ __device__ void init(int M, int N, int G_, int c_) { nM = M / BM; nN = N / BM; nwg = nM * nN; G = G_; c = c_; }
    __host__ __device__ bool next(int i, Unit& u) const {
        const long L = (long)i * G + c; if (L >= nwg) return false;
        int wgid = (int)L; { const int q = nwg / NXCD, r = nwg % NXCD, xcd = wgid % NXCD, off = wgid / NXCD; wgid = (xcd < r ? xcd * (q + 1) : r * (q + 1) + (xcd - r) * q) + off; }
        const int nig = WGM * nN, gid = wgid / nig, fm = gid * WGM, gsz = (nM - fm) < WGM ? (nM - fm) : WGM;
        u.pm = fm + ((wgid % nig) % gsz); u.pn = (wgid % nig) / gsz; u.z = 0; return true;
    }
    __device__ __forceinline__ void a_ready(const Unit&) const {}
    __device__ __forceinline__ void done(const Unit&) const {}
};

typedef float f32x2 __attribute__((ext_vector_type(2)));
typedef unsigned u32x2 __attribute__((ext_vector_type(2)));
__device__ __forceinline__ unsigned cvt_pk_bf16(float lo, float hi) { unsigned r; asm volatile("v_cvt_pk_bf16_f32 %0, %1, %2" : "=v"(r) : "v"(lo), "v"(hi)); return r; }
__device__ __forceinline__ float bf_lo(unsigned w) { return __uint_as_float(w << 16); }
__device__ __forceinline__ float bf_hi(unsigned w) { return __uint_as_float(w & 0xffff0000u); }
__device__ __forceinline__ f32x2 gelu_pk(f32x2 v) {
    const f32x2 av = __builtin_elementwise_abs(v), d = av * 0.2316418882f + 1.0f;
    f32x2 t; t.x = __builtin_amdgcn_rcpf(d.x); t.y = __builtin_amdgcn_rcpf(d.y);
    f32x2 q = t * 0.5307027145f + (-0.7265760135f); q = q * t + 0.7107068705f; q = q * t + (-0.142248368f); q = q * t + 0.127414796f; q = q * t;
    const f32x2 s = (v * v) * (-0.72134752044f);
    f32x2 e; e.x = __builtin_amdgcn_exp2f(s.x); e.y = __builtin_amdgcn_exp2f(s.y);
    const f32x2 m = v * (q * e), r = v - m;
    f32x2 o; o.x = v.x < 0.f ? m.x : r.x; o.y = v.y < 0.f ? m.y : r.y; return o;
}
__device__ __forceinline__ f32x4 gelu4(f32x4 v) { f32x2 a = gelu_pk((f32x2){v[0], v[1]}), b = gelu_pk((f32x2){v[2], v[3]}); return (f32x4){a.x, a.y, b.x, b.y}; }
__device__ __forceinline__ float exp_neg(float x) { return __builtin_amdgcn_exp2f(fminf(-x * 1.44269504089f, 100.f)); }
__device__ __forceinline__ float ld_agent(const float* p) { return __hip_atomic_load(p, __ATOMIC_RELAXED, __HIP_MEMORY_SCOPE_AGENT); }
__device__ __forceinline__ u32x4 pack8(f32x4 a, f32x4 b) { u32x4 w; w.x = cvt_pk_bf16(a[0], a[1]); w.y = cvt_pk_bf16(a[2], a[3]); w.z = cvt_pk_bf16(b[0], b[1]); w.w = cvt_pk_bf16(b[2], b[3]); return w; }
__device__ __forceinline__ void unpack8(u32x4 w, f32x4& a, f32x4& b) { a = (f32x4){bf_lo(w.x), bf_hi(w.x), bf_lo(w.y), bf_hi(w.y)}; b = (f32x4){bf_lo(w.z), bf_hi(w.z), bf_lo(w.w), bf_hi(w.w)}; }

constexpr int D_ = 2048, DS_ = 1024, FF_ = 5632;
constexpr float EPS_ = 1e-6f;
struct EpiIn {
    static constexpr bool PERM = true, AFTER_DRAIN = false, KEEP = false;
    bf16_t *UV, *P, *R, *GB; float *vsum, *vsq;
    __device__ __forceinline__ void operator()(f32x4 (&acc)[2][2][4][2], const Unit& u, int wr, int wc, int fr, int fq) const {
        const int row0 = u.pm * BM + wr * 64 + fr, cl = wc * 32 + 8 * fq;
        if (u.pn < 8) {
            const bool isv = u.pn >= 4;
#pragma unroll
            for (int ai = 0; ai < 2; ++ai)
#pragma unroll
                for (int m = 0; m < 4; ++m) { const int row = row0 + ai * HALF + m * 16; float s = 0.f, q = 0.f;
#pragma unroll
                    for (int bj = 0; bj < 2; ++bj) { const f32x4 a = gelu4(acc[ai][bj][m][0]), b = gelu4(acc[ai][bj][m][1]);
                        s += ((a[0] + a[1]) + (a[2] + a[3])) + ((b[0] + b[1]) + (b[2] + b[3]));
                        q += ((a[0] * a[0] + a[1] * a[1]) + (a[2] * a[2] + a[3] * a[3])) + ((b[0] * b[0] + b[1] * b[1]) + (b[2] * b[2] + b[3] * b[3]));
                        *(u32x4*)(UV + (size_t)row * D_ + u.pn * BM + bj * HALF + cl) = pack8(a, b); }
                    if (isv) { s += __shfl_xor(s, 16); s += __shfl_xor(s, 32); q += __shfl_xor(q, 16); q += __shfl_xor(q, 32);
                        if (fq == 0) { atomicAdd(vsum + row, s); atomicAdd(vsq + row, q); } } }
        } else if (u.pn < 12) {
#pragma unroll
            for (int ai = 0; ai < 2; ++ai)
#pragma unroll
                for (int m = 0; m < 4; ++m) { const int row = row0 + ai * HALF + m * 16;
#pragma unroll
                    for (int bj = 0; bj < 2; ++bj) *(u32x4*)(P + (size_t)row * DS_ + (u.pn - 8) * BM + bj * HALF + cl) = pack8(acc[ai][bj][m][0], acc[ai][bj][m][1]); }
        } else {
            const int ch = (u.pn - 12) * HALF + cl;
#pragma unroll
            for (int ai = 0; ai < 2; ++ai)
#pragma unroll
                for (int m = 0; m < 4; ++m) { const int row = row0 + ai * HALF + m * 16; f32x4 r[2], g[2];
#pragma unroll
                    for (int n = 0; n < 2; ++n)
#pragma unroll
                        for (int e = 0; e < 4; ++e) { const float ea = exp_neg(acc[ai][0][m][n][e]), eb = exp_neg(acc[ai][1][m][n][e]);
                            const float ia = __builtin_amdgcn_rcpf(1.f + ea), ib = __builtin_amdgcn_rcpf(1.f + eb);
                            r[n][e] = (1.f + eb) * ia; g[n][e] = ib; }
                    *(u32x4*)(R + (size_t)row * D_ + ch) = pack8(r[0], r[1]); *(u32x4*)(GB + (size_t)row * D_ + ch) = pack8(g[0], g[1]); }
        }
    }
};
struct EpiMerge {
    static constexpr bool PERM = true, AFTER_DRAIN = false, KEEP = true;
    const bf16_t *R, *GB; bf16_t* MG;
    __device__ __forceinline__ void operator()(f32x4 (&acc)[2][2][4][2], const Unit& u, int wr, int wc, int fr, int fq) const {
        const int row0 = u.pm * BM + wr * 64 + fr, cl = u.pn * BM + wc * 32 + 8 * fq;
#pragma unroll
        for (int ai = 0; ai < 2; ++ai)
#pragma unroll
            for (int m = 0; m < 4; ++m) { const size_t off = (size_t)(row0 + ai * HALF + m * 16) * D_ + cl;
#pragma unroll
                for (int bj = 0; bj < 2; ++bj) {
                    if (u.z == 0) { f32x4 a, b; unpack8(*(const u32x4*)(R + off + bj * HALF), a, b); acc[ai][bj][m][0] *= a; acc[ai][bj][m][1] *= b; }
                    else { f32x4 a, b; unpack8(*(const u32x4*)(GB + off + bj * HALF), a, b); st16_wt(MG + off + bj * HALF, pack8(acc[ai][bj][m][0] * a, acc[ai][bj][m][1] * b)); } } }
    }
};
struct EpiSwiGLU {
    static constexpr bool PERM = true, AFTER_DRAIN = false, KEEP = false;
    bf16_t* H; const PG8_LAS float* rsT;
    __device__ __forceinline__ void operator()(f32x4 (&acc)[2][2][4][2], const Unit& u, int wr, int wc, int fr, int fq) const {
        const int row0 = u.pm * BM + wr * 64 + fr, cl = u.pn * HALF + wc * 32 + 8 * fq;
#pragma unroll
        for (int ai = 0; ai < 2; ++ai)
#pragma unroll
            for (int m = 0; m < 4; ++m) { f32x4 o[2]; const float rs = rsT[u.z * BM + wr * 64 + fr + ai * HALF + m * 16];
#pragma unroll
                for (int n = 0; n < 2; ++n)
#pragma unroll
                    for (int e = 0; e < 4; ++e) { const float g = acc[ai][0][m][n][e] * rs; o[n][e] = g * __builtin_amdgcn_rcpf(1.f + exp_neg(g)) * (acc[ai][1][m][n][e] * rs); }
                *(u32x4*)(H + (size_t)(row0 + ai * HALF + m * 16) * FF_ + cl) = pack8(o[0], o[1]); }
    }
};
__device__ __forceinline__ void row_sumsq_add(const f32x4 (&v)[2][2][4][2], float* st, int row0, int fq) {
#pragma unroll
    for (int ai = 0; ai < 2; ++ai)
#pragma unroll
        for (int m = 0; m < 4; ++m) { float s = 0.f;
#pragma unroll
            for (int bj = 0; bj < 2; ++bj)
#pragma unroll
                for (int n = 0; n < 2; ++n) { const f32x4 x = v[ai][bj][m][n]; s += (x[0] * x[0] + x[1] * x[1]) + (x[2] * x[2] + x[3] * x[3]); }
            s += __shfl_xor(s, 16); s += __shfl_xor(s, 32);
            if (fq == 0) atomicAdd(st + row0 + ai * HALF + m * 16, s); }
}
struct EpiNorm1 {
    static constexpr bool PERM = false, AFTER_DRAIN = true, KEEP = false;
    const float* x; bf16_t* xg; const float* g1; float *st1, *st2; unsigned *pword, *tmo;
    __device__ __forceinline__ void fused(f32x4 (&acc)[2][2][4][2], const Unit& u, int wr, int wc, int fr, int fq, PG8_LAS unsigned char* lds, int wid, int lane) const {
        const int row0 = u.pm * BM + wr * 64 + fr, col0 = u.pn * BM + wc * 32 + 4 * fq;
        row_sumsq_add(acc, st1, row0, fq);
        panel_barrier<false>(pword, tmo);
#pragma unroll
        for (int ai = 0; ai < 2; ++ai)
#pragma unroll
            for (int m = 0; m < 4; ++m) { const int row = row0 + ai * HALF + m * 16; const float rs = __builtin_amdgcn_rsqf(ld_agent(st1 + row) * (1.f / D_) + EPS_);
#pragma unroll
                for (int bj = 0; bj < 2; ++bj)
#pragma unroll
                    for (int n = 0; n < 2; ++n) { const size_t off = (size_t)row * D_ + col0 + bj * HALF + n * 16; const f32x4 g = *(const f32x4*)(g1 + col0 + bj * HALF + n * 16);
                        const f32x4 v = *(const f32x4*)(x + off) + acc[ai][bj][m][n] * rs * g; acc[ai][bj][m][n] = v;
                        u32x2 w; w.x = cvt_pk_bf16(v[0], v[1]); w.y = cvt_pk_bf16(v[2], v[3]);
                        *(PG8_LAS u32x2*)(lds + (wr * 64 + fr + ai * HALF + m * 16) * 528 + (wc * 32 + 4 * fq + bj * HALF + n * 16) * 2) = w; }
                asm volatile("" ::: "memory"); }
        row_sumsq_add(acc, st2, row0, fq);
        asm volatile("s_waitcnt lgkmcnt(0)" ::: "memory"); __builtin_amdgcn_s_barrier(); asm volatile("" ::: "memory");
        const int tid = wid * 64 + lane;
#pragma unroll
        for (int k = 0; k < 16; ++k) { const int q = tid + 512 * k, row = q >> 5, ch = q & 31;
            *(u32x4*)(xg + (size_t)(u.pm * BM + row) * D_ + u.pn * BM + 8 * ch) = *(const PG8_LAS u32x4*)(lds + row * 528 + ch * 16); }
    }
};
struct EpiNorm2 {
    static constexpr bool PERM = false, AFTER_DRAIN = true, KEEP = false;
    float* out; const bf16_t* x1b; const float* g3; float* st3; unsigned *pword, *tmo;
    __device__ __forceinline__ void fused(f32x4 (&acc)[2][2][4][2], const Unit& u, int wr, int wc, int fr, int fq, PG8_LAS unsigned char*, int, int) const {
        const int row0 = u.pm * BM + wr * 64 + fr, col0 = u.pn * BM + wc * 32 + 4 * fq;
        row_sumsq_add(acc, st3, row0, fq);
        panel_barrier<false>(pword, tmo);
#pragma unroll
        for (int ai = 0; ai < 2; ++ai)
#pragma unroll
            for (int m = 0; m < 4; ++m) { const int row = row0 + ai * HALF + m * 16; const float rs = __builtin_amdgcn_rsqf(ld_agent(st3 + row) * (1.f / D_) + EPS_);
#pragma unroll
                for (int bj = 0; bj < 2; ++bj)
#pragma unroll
                    for (int n = 0; n < 2; ++n) { const size_t off = (size_t)row * D_ + col0 + bj * HALF + n * 16; const f32x4 g = *(const f32x4*)(g3 + col0 + bj * HALF + n * 16);
                        const u32x2 xb = *(const u32x2*)(x1b + off); const f32x4 x1v = (f32x4){bf_lo(xb.x), bf_hi(xb.x), bf_lo(xb.y), bf_hi(xb.y)};
                        *(f32x4*)(out + off) = x1v + acc[ai][bj][m][n] * rs * g; }
                asm volatile("" ::: "memory"); }
    }
};
struct EpiNull {
    static constexpr bool PERM = false, AFTER_DRAIN = false, KEEP = false;
    float* sink;
    __device__ __forceinline__ void operator()(f32x4 (&acc)[2][2][4][2], const Unit& u, int wr, int wc, int fr, int fq) const {
        float s = 0.f;
#pragma unroll
        for (int ai = 0; ai < 2; ++ai)
#pragma unroll
            for (int m = 0; m < 4; ++m)
#pragma unroll
                for (int bj = 0; bj < 2; ++bj)
#pragma unroll
                    for (int n = 0; n < 2; ++n) s += acc[ai][bj][m][n][0] + acc[ai][bj][m][n][1] + acc[ai][bj][m][n][2] + acc[ai][bj][m][n][3];
        if (s == 1234.5678f) sink[0] = s;
    }
};
struct IdxOrder {
    StaticOrder so;
    __device__ bool next(int i, Unit& u) const { if (!so.next(i, u)) return false; u.z = i; return true; }
    __device__ __forceinline__ void a_ready(const Unit&) const {}
    __device__ __forceinline__ void done(const Unit&) const {}
};
struct RangeOrder {
    StaticOrder so; int base, count;
    __device__ bool next(int i, Unit& u) const { return i < count && so.next(base + i, u); }
    __device__ __forceinline__ void a_ready(const Unit&) const {}
    __device__ __forceinline__ void done(const Unit&) const {}
};
struct PairOrder {
    StaticOrder so;
    __device__ bool next(int i, Unit& u) const { if (!so.next(i >> 1, u)) return false; u.z = i & 1; return true; }
    __device__ __forceinline__ void a_ready(const Unit&) const {}
    __device__ __forceinline__ void done(const Unit&) const {}
};
template <class Epi, class Sched, bool ALIGN_EPI = false, bool SP2 = false>
__device__ __forceinline__ void gemm_phase(PG8_LAS unsigned char* lds, const Gemm g, const Sched& S, const Epi& E) {
    const int tid = threadIdx.x, wid = __builtin_amdgcn_readfirstlane(tid >> 6), lane = tid & 63, wr = wid >> 2, wc = wid & 3, fr = lane & 15, fq = lane >> 4;
    const int K = g.K, nt = K / BK;
    unsigned voffA[2], voffB[2];
#pragma unroll
    for (int i = 0; i < 2; ++i) { int R, C; stage_rc(tid * 16 + i * 8192, R, C); const int Rb = Epi::PERM ? ((R & ~31) + perm32(R & 31)) : R;
        voffA[i] = (unsigned)(R * K + C) * 2u; voffB[i] = (unsigned)(Rb * K + C) * 2u; }
    const size_t kstep = (size_t)(BK * 2);
    const size_t hstep = (size_t)HALF * K * 2;
    const size_t tstep = 2 * hstep;
    const unsigned ldsw = (unsigned)wid * 1024u;
    const int aoff = lds_byte(wr * 64 + fr, fq * 8), boff = lds_byte(wc * 32 + fr, fq * 8);
#define PG8_SA(b, h) (((b) * 2 + (h)) * HTB)
#define PG8_SB(b, h) ((4 + (b) * 2 + (h)) * HTB)
#define PG8_STAGE(bufoff, gbase, voff) do { _Pragma("unroll") for (int _i = 0; _i < 2; ++_i) \
        __builtin_amdgcn_global_load_lds((const unsigned*)((const char*)(gbase) + (voff)[_i]), (PG8_LAS unsigned*)(lds + (bufoff) + ldsw + _i * 8192), 16, 0, 0); } while (0)
#define PG8_LDA(dst, b, h) do { _Pragma("unroll") for (int m = 0; m < 4; ++m) _Pragma("unroll") for (int k = 0; k < 2; ++k) dst[m][k] = *(const PG8_LAS bf16x8*)(lds + PG8_SA(b, h) + aoff + m * 2048 + k * 1024); } while (0)
#define PG8_LDB(dst, b, h) do { _Pragma("unroll") for (int n = 0; n < 2; ++n) _Pragma("unroll") for (int k = 0; k < 2; ++k) dst[n][k] = *(const PG8_LAS bf16x8*)(lds + PG8_SB(b, h) + boff + n * 2048 + k * 1024); } while (0)
#define PG8_MMA(ai, bj, At, Bt) do { __builtin_amdgcn_s_setprio(1); _Pragma("unroll") for (int m = 0; m < 4; ++m) _Pragma("unroll") for (int n = 0; n < 2; ++n) _Pragma("unroll") for (int k = 0; k < 2; ++k) \
        acc[ai][bj][m][n] = __builtin_amdgcn_mfma_f32_16x16x32_bf16(Bt[n][k], At[m][k], acc[ai][bj][m][n], 0, 0, 0); __builtin_amdgcn_s_setprio(0); } while (0)
#define PG8_WAIT_V(n) asm volatile("s_waitcnt vmcnt(" #n ")" ::: "memory")
#define PG8_WAIT_L(n) asm volatile("s_waitcnt lgkmcnt(" #n ")" ::: "memory")
#define PG8_BAR __builtin_amdgcn_s_barrier()
#define PG8_SCHED __builtin_amdgcn_sched_barrier(0)
    Unit cur, nxt; int ui = 0;
    if (!S.next(0, cur)) return;
    f32x4 acc[2][2][4][2];
#pragma unroll
    for (int a = 0; a < 2; ++a)
#pragma unroll
        for (int b = 0; b < 2; ++b)
#pragma unroll
            for (int m = 0; m < 4; ++m)
#pragma unroll
                for (int n = 0; n < 2; ++n) acc[a][b][m][n] = (f32x4){0.f, 0.f, 0.f, 0.f};
    bf16x8 At[4][2], B0[2][2], B1[2][2];
    const char* cA = (const char*)(cur.z ? g.A1 : g.A0) + (size_t)cur.pm * tstep; const char* cB = (const char*)(cur.z ? g.B1 : g.B0) + (size_t)cur.pn * tstep;
    S.a_ready(cur);
    if constexpr (SP2) {
        PG8_STAGE(PG8_SB(0, 0), cB, voffB); PG8_STAGE(PG8_SB(0, 1), cB + hstep, voffB); PG8_STAGE(PG8_SA(0, 0), cA, voffA); PG8_STAGE(PG8_SA(0, 1), cA + hstep, voffA);
        if (wr == 1) PG8_BAR;
        PG8_WAIT_V(2); PG8_BAR;
        PG8_STAGE(PG8_SB(1, 0), cB + kstep, voffB); PG8_STAGE(PG8_SA(1, 0), cA + kstep, voffA); PG8_STAGE(PG8_SB(1, 1), cB + hstep + kstep, voffB);
        PG8_WAIT_V(6); PG8_BAR;
    } else {
        PG8_STAGE(PG8_SB(0, 0), cB, voffB); PG8_STAGE(PG8_SA(0, 0), cA, voffA); PG8_STAGE(PG8_SB(0, 1), cB + hstep, voffB); PG8_STAGE(PG8_SA(0, 1), cA + hstep, voffA);
        if (wr == 1) PG8_BAR;
        PG8_WAIT_V(4); PG8_BAR;
        PG8_STAGE(PG8_SB(1, 0), cB + kstep, voffB); PG8_STAGE(PG8_SA(1, 0), cA + kstep, voffA); PG8_STAGE(PG8_SB(1, 1), cB + hstep + kstep, voffB);
        PG8_WAIT_V(6); PG8_BAR;
    }
    for (;;) {
        const bool has_next = S.next(ui + 1, nxt);
        const char* nA = has_next ? (const char*)(nxt.z ? g.A1 : g.A0) + (size_t)nxt.pm * tstep : cA; const char* nB = has_next ? (const char*)(nxt.z ? g.B1 : g.B0) + (size_t)nxt.pn * tstep : cB;
        for (int t = 0; t < nt; t += 2) {
            const bool last = (t == nt - 2);
            const char* a1 = cA + (size_t)(t + 1) * kstep;
            const char* a2 = last ? nA : cA + (size_t)(t + 2) * kstep; const char* b2 = last ? nB : cB + (size_t)(t + 2) * kstep;
            const char* a3 = a2 + kstep; const char* b3 = b2 + kstep;
            if (last && has_next) S.a_ready(nxt);
            if constexpr (SP2) {
            PG8_LDB(B0, 0, 0); PG8_LDB(B1, 0, 1); PG8_SCHED; PG8_LDA(At, 0, 0); PG8_STAGE(PG8_SA(1, 1), a1 + hstep, voffA);
            PG8_WAIT_V(8); PG8_WAIT_L(0); PG8_BAR; PG8_MMA(0, 0, At, B0); PG8_MMA(0, 1, At, B1); PG8_BAR; PG8_SCHED;
            PG8_LDA(At, 0, 1); PG8_STAGE(PG8_SB(0, 0), b2, voffB); PG8_STAGE(PG8_SB(0, 1), b2 + hstep, voffB); PG8_STAGE(PG8_SA(0, 0), a2, voffA);
            PG8_WAIT_V(8); PG8_WAIT_L(0); PG8_BAR; PG8_MMA(1, 0, At, B0); PG8_MMA(1, 1, At, B1); PG8_BAR; PG8_SCHED;
            PG8_LDB(B0, 1, 0); PG8_LDB(B1, 1, 1); PG8_SCHED; PG8_LDA(At, 1, 0); PG8_STAGE(PG8_SA(0, 1), a2 + hstep, voffA);
            PG8_WAIT_V(8); PG8_WAIT_L(0); PG8_BAR; PG8_MMA(0, 0, At, B0); PG8_MMA(0, 1, At, B1); PG8_BAR; PG8_SCHED;
            PG8_LDA(At, 1, 1); PG8_STAGE(PG8_SB(1, 0), b3, voffB); PG8_STAGE(PG8_SB(1, 1), b3 + hstep, voffB); PG8_STAGE(PG8_SA(1, 0), a3, voffA);
            PG8_WAIT_V(8); PG8_WAIT_L(0); PG8_BAR; PG8_MMA(1, 0, At, B0); PG8_MMA(1, 1, At, B1); PG8_BAR; PG8_SCHED;
            } else {
            PG8_LDB(B0, 0, 0); PG8_SCHED; PG8_LDA(At, 0, 0); PG8_STAGE(PG8_SA(1, 1), a1 + hstep, voffA);
            PG8_WAIT_L(8); PG8_BAR; PG8_WAIT_L(0); PG8_MMA(0, 0, At, B0); PG8_BAR; PG8_SCHED;
            PG8_LDB(B1, 0, 1); PG8_STAGE(PG8_SB(0, 0), b2, voffB);
            PG8_BAR; PG8_WAIT_L(0); PG8_MMA(0, 1, At, B1); PG8_BAR;
            PG8_LDA(At, 0, 1); PG8_STAGE(PG8_SA(0, 0), a2, voffA);
            PG8_BAR; PG8_WAIT_L(0); PG8_MMA(1, 0, At, B0); PG8_BAR; PG8_SCHED;
            PG8_STAGE(PG8_SB(0, 1), b2 + hstep, voffB);
            PG8_WAIT_V(6); PG8_BAR; PG8_MMA(1, 1, At, B1); PG8_BAR;
            PG8_LDB(B0, 1, 0); PG8_SCHED; PG8_LDA(At, 1, 0); PG8_STAGE(PG8_SA(0, 1), a2 + hstep, voffA);
            PG8_WAIT_L(8); PG8_BAR; PG8_WAIT_L(0); PG8_MMA(0, 0, At, B0); PG8_BAR; PG8_SCHED;
            PG8_LDB(B1, 1, 1); PG8_STAGE(PG8_SB(1, 0), b3, voffB);
            PG8_BAR; PG8_WAIT_L(0); PG8_MMA(0, 1, At, B1); PG8_BAR;
            PG8_LDA(At, 1, 1); PG8_STAGE(PG8_SA(1, 0), a3, voffA);
            PG8_BAR; PG8_WAIT_L(0); PG8_MMA(1, 0, At, B0); PG8_BAR; PG8_SCHED;
            PG8_STAGE(PG8_SB(1, 1), b3 + hstep, voffB);
            PG8_WAIT_V(6); PG8_BAR; PG8_MMA(1, 1, At, B1); PG8_BAR;
            }
        }
        if constexpr (ALIGN_EPI) { if (wr == 0) PG8_BAR; }
        if constexpr (!Epi::AFTER_DRAIN) { E(acc, cur, wr, wc, fr, fq); S.done(cur); }
        if (!has_next) break;
        if (!(Epi::KEEP && cur.z == 0))
#pragma unroll
        for (int a = 0; a < 2; ++a)
#pragma unroll
            for (int b = 0; b < 2; ++b)
#pragma unroll
                for (int m = 0; m < 4; ++m)
#pragma unroll
                    for (int n = 0; n < 2; ++n) acc[a][b][m][n] = (f32x4){0.f, 0.f, 0.f, 0.f};
        cur = nxt; cA = nA; cB = nB; ++ui;
        if constexpr (ALIGN_EPI) { if (wr == 1) PG8_BAR; }
    }
    PG8_WAIT_V(0);
    if constexpr (!ALIGN_EPI) { if (wr == 0) PG8_BAR; }
    PG8_BAR;
    if constexpr (Epi::AFTER_DRAIN) { E.fused(acc, cur, wr, wc, fr, fq, lds, wid, lane); S.done(cur); }
#undef PG8_SA
#undef PG8_SB
#undef PG8_STAGE
#undef PG8_LDA
#undef PG8_LDB
#undef PG8_MMA
#undef PG8_WAIT_V
#undef PG8_WAIT_L
#undef PG8_BAR
#undef PG8_SCHED
}
}

constexpr int NWAVES = 8, NTHREADS = 512;
constexpr int SEQ = 4096, M = 8192, D = 2048, DS = 1024, DP = 1024, DIN = 7168, FF = 5632;
constexpr float EPS = 1e-6f;
constexpr size_t MiB = 1u << 20;
constexpr size_t WS_STAT = 0;
constexpr size_t WS_BAR = 1 * MiB;
constexpr int PW_BASE = 4096, PW_SEAM = 32 * 64;
constexpr size_t WS_WIN = 2 * MiB;
constexpr size_t WS_XG = 2 * MiB;
constexpr size_t WS_WAB = 34 * MiB;
constexpr size_t WS_WOUT = 42 * MiB;
constexpr size_t WS_WGU = 50 * MiB;
constexpr size_t WS_WDN = 94 * MiB;
constexpr size_t WS_PWT = 116 * MiB;
constexpr size_t WS_SGW = 116 * MiB + 512 * 1024;
constexpr size_t WS_XN = 117 * MiB;
constexpr size_t WS_UV = 149 * MiB;
constexpr size_t WS_P = 181 * MiB;
constexpr size_t WS_R = 197 * MiB;
constexpr size_t WS_GB = 229 * MiB;
constexpr size_t WS_HID = 149 * MiB;
constexpr size_t WS_END = 261 * MiB;
static_assert(WS_HID + (size_t)M * FF * 2 <= WS_END && WS_WDN + (size_t)D * FF * 2 <= WS_PWT && WS_WGU + (size_t)2 * FF * D * 2 <= WS_WDN, "d_ws map");
constexpr int MISC_OFF = 147392;
constexpr int LDS_BYTES = 147456;

typedef unsigned short bf16;
typedef pg8::f32x4 f32x4;
typedef pg8::u32x4 u32x4;
typedef pg8::u32x2 u32x2;
typedef pg8::bf16x8 bf16x8;
using pg8::cvt_pk_bf16; using pg8::bf_lo; using pg8::bf_hi; using pg8::pack8; using pg8::unpack8; using pg8::ld_agent;

struct Args { const float* in[18]; float* out; unsigned char* ws; };
struct Frame {
    LAS unsigned char* lds; int tid, lane, wave, G, bid;
    const float *x, *norm1_pre, *w_in, *v_ln_g, *v_ln_b, *sgu_w, *sgu_b, *pool_w, *pool_scale, *w_a, *w_b, *w_out, *norm1_post, *norm2_pre, *w_gate, *w_up, *w_down, *norm2_post;
    float* out; float *vsum, *vsq, *st1, *st2, *st3;
    bf16 *WIN, *WAB, *WOUT, *WGU, *WDN, *PWT, *SGW, *XN, *XG, *YA, *YB, *UV, *MG, *P, *R, *GB, *HID;
};
__device__ __forceinline__ float wave_sum(float v) {
#pragma unroll
    for (int o = 1; o < 64; o <<= 1) v += __shfl_xor(v, o);
    return v;
}
struct TItem { const float* src; bf16* dst; const float* ks; int N, ldo, mode, pad; };
__device__ __forceinline__ TItem mk_item(const float* W, int N, int k0, int n0, bf16* WT, int ldo, int orow0, const float* kscale = nullptr, int mode = 0) {
    TItem t; t.mode = mode; t.pad = 0; t.src = W + (size_t)k0 * N + n0; t.dst = WT + (size_t)orow0 * ldo + k0; t.ks = kscale ? kscale + k0 : nullptr; t.N = N; t.ldo = ldo; return t; }
__device__ __forceinline__ void titem_load(const TItem& t, f32x4 (&v)[16], int lane) {
    const int lr = lane >> 4, lc = 4 * (lane & 15);
#pragma unroll
    for (int i = 0; i < 16; ++i) v[i] = __builtin_nontemporal_load((const f32x4*)(t.src + (size_t)(4 * i + lr) * t.N + lc));
}
template <bool NT>
__device__ __forceinline__ void titem_finish(const TItem& t, const f32x4 (&v)[16], LAS float* scr, int lane) {
    const int lr = lane >> 4, lc = 4 * (lane & 15);
#pragma unroll
    for (int i = 0; i < 16; ++i) { const int kk = 4 * i + lr; scr[kk * 65 + lc + 0] = v[i][0]; scr[kk * 65 + lc + 1] = v[i][1]; scr[kk * 65 + lc + 2] = v[i][2]; scr[kk * 65 + lc + 3] = v[i][3]; }
    asm volatile("s_waitcnt lgkmcnt(0)" ::: "memory");
    const int c = lane & 7;
    f32x4 ks0 = (f32x4){1.f, 1.f, 1.f, 1.f}, ks1 = ks0;
    if (t.ks) { ks0 = *(const f32x4*)(t.ks + 8 * c); ks1 = *(const f32x4*)(t.ks + 8 * c + 4); }
#pragma unroll
    for (int jj = 0; jj < 8; ++jj) { const int n = 8 * jj + (lane >> 3); const LAS float* s = scr + (8 * c) * 65 + n;
        u32x4 o; o.x = cvt_pk_bf16(s[0 * 65] * ks0[0], s[1 * 65] * ks0[1]); o.y = cvt_pk_bf16(s[2 * 65] * ks0[2], s[3 * 65] * ks0[3]); o.z = cvt_pk_bf16(s[4 * 65] * ks1[0], s[5 * 65] * ks1[1]); o.w = cvt_pk_bf16(s[6 * 65] * ks1[2], s[7 * 65] * ks1[3]);
        if (t.mode == 2) st16_wt(t.dst + (size_t)n * t.ldo + 8 * c, o); else if (NT) __builtin_nontemporal_store(o, (u32x4*)(t.dst + (size_t)n * t.ldo + 8 * c)); else *(u32x4*)(t.dst + (size_t)n * t.ldo + 8 * c) = o; }
    asm volatile("s_waitcnt lgkmcnt(0)" ::: "memory");
}
constexpr int I_IN = (D / 64) * (DIN / 64), I_A = (DS / 64) * (D / 64), I_OUT = (D / 64) * (D / 64), I_G = (D / 64) * (FF / 64), I_D = (FF / 64) * (D / 64), I_PW = 4 * 16;
__device__ __forceinline__ int win_orow(int n0) { if (n0 < 3072) return n0; const int q = n0 - 3072, isb = q / D, c = q % D; return 3072 + (c / 128) * 256 + isb * 128 + (c % 128); }
constexpr int I_INH = 32 * 56;
template <int SET>
__device__ __forceinline__ TItem decode_item(const Frame& F, int r) {
    if constexpr (SET == 0) {
        if (r < I_INH) { const int e = r % 56, k0 = 64 * (r / 56), n0 = 64 * (e < 28 ? e : (e < 42 ? 24 + e : 42 + e)); return mk_item(F.w_in, DIN, k0, n0, F.WIN, D, win_orow(n0)); } r -= I_INH;
        const int g = r / 16, rr = r % 16; return mk_item(F.pool_w + (size_t)g * 65536, 256, 64 * (rr / 4), 64 * (rr % 4), F.PWT + (size_t)g * 65536, 256, 64 * (rr % 4));
    } else if constexpr (SET == 3) {
        const int l = r % 56, k0 = 64 * (r / 56), n0 = 64 * (l < 24 ? 28 + l : (l < 42 ? 42 + l : 56 + l));
        return mk_item(F.w_in, DIN, k0, n0, F.WIN, D, win_orow(n0), nullptr, 2);
    } else if constexpr (SET == 1) {
        if (r < I_A) { const int nblk = D / 64; return mk_item(F.w_a, D, 64 * (r / nblk), 64 * (r % nblk), F.WAB, DS, 64 * (r % nblk)); } r -= I_A;
        if (r < I_A) { const int nblk = D / 64; return mk_item(F.w_b, D, 64 * (r / nblk), 64 * (r % nblk), F.WAB + (size_t)D * DS, DS, 64 * (r % nblk)); } r -= I_A;
        if (r < I_OUT) { const int nblk = D / 64; return mk_item(F.w_out, D, 64 * (r / nblk), 64 * (r % nblk), F.WOUT, D, 64 * (r % nblk)); } r -= I_OUT;
        if (r < I_G) { const int nblk = FF / 64, n0 = 64 * (r % nblk); return mk_item(F.w_gate, FF, 64 * (r / nblk), n0, F.WGU, D, (n0 / 128) * 256 + (n0 % 128), F.norm2_pre); } r -= I_G;
        const int nblk = FF / 64, n0 = 64 * (r % nblk); return mk_item(F.w_up, FF, 64 * (r / nblk), n0, F.WGU, D, (n0 / 128) * 256 + 128 + (n0 % 128), F.norm2_pre);
    } else {
        const int nblk = D / 64; return mk_item(F.w_down, D, 64 * (r / nblk), 64 * (r % nblk), F.WDN, FF, 64 * (r % nblk));
    }
}
template <int SET>
__device__ __forceinline__ void convert_weights(const Frame& F, int gw, int NGW) {
    LAS float* scr = (LAS float*)(F.lds + F.wave * 16640);
    constexpr int NITEMS = SET == 0 ? I_INH + I_PW : (SET == 1 ? 2 * I_A + I_OUT + 2 * I_G : (SET == 3 ? I_INH : I_D));
    int it = gw; if (it >= NITEMS) return;
    TItem cur = decode_item<SET>(F, it); f32x4 v[16]; titem_load(cur, v, F.lane);
    for (;;) {
        const int nit = it + NGW; const bool hn = nit < NITEMS;
        TItem nx = cur; f32x4 nv[16];
        if (hn) { nx = decode_item<SET>(F, nit); titem_load(nx, nv, F.lane); }
        titem_finish<SET == 1>(cur, v, scr, F.lane);
        if (!hn) break;
        cur = nx; it = nit;
#pragma unroll
        for (int i = 0; i < 16; ++i) v[i] = nv[i];
    }
}
__device__ __forceinline__ void p0_prologue(const Frame& F) {
    const int gw = F.bid * NWAVES + F.wave, NGW = F.G * NWAVES;
    for (int i = F.bid * NTHREADS + F.tid; i < 5 * M; i += F.G * NTHREADS) F.vsum[i] = 0.f;
    for (int i = (F.bid * NTHREADS + F.tid) * 8; i < 8 * 128 * 128; i += F.G * NTHREADS * 8) {
        const f32x4 a = *(const f32x4*)(F.sgu_w + i), b = *(const f32x4*)(F.sgu_w + i + 4); *(u32x4*)(F.SGW + i) = pack8(a, b); }
    {
        const f32x4* gr = (const f32x4*)F.norm1_pre + F.lane;
        int m = gw; f32x4 v[8];
        if (m < M) { const f32x4* xr = (const f32x4*)(F.x + (size_t)m * D) + F.lane;
#pragma unroll
            for (int j = 0; j < 8; ++j) v[j] = xr[64 * j]; }
        while (m < M) {
            const int nm = m + NGW; f32x4 nv[8];
            if (nm < M) { const f32x4* xr = (const f32x4*)(F.x + (size_t)nm * D) + F.lane;
#pragma unroll
                for (int j = 0; j < 8; ++j) nv[j] = xr[64 * j]; }
            float s = 0.f;
#pragma unroll
            for (int j = 0; j < 8; ++j) s += (v[j][0] * v[j][0] + v[j][1] * v[j][1]) + (v[j][2] * v[j][2] + v[j][3] * v[j][3]);
            const float rs = __builtin_amdgcn_rsqf(wave_sum(s) * (1.f / D) + EPS);
            u32x2* o = (u32x2*)(F.XN + (size_t)m * D) + F.lane;
#pragma unroll
            for (int j = 0; j < 8; ++j) { const f32x4 t = v[j] * rs * gr[64 * j]; u32x2 w; w.x = cvt_pk_bf16(t[0], t[1]); w.y = cvt_pk_bf16(t[2], t[3]); o[64 * j] = w; }
            if (nm < M) {
#pragma unroll
                for (int j = 0; j < 8; ++j) v[j] = nv[j]; }
            m = nm;
        }
    }
    convert_weights<0>(F, gw, NGW);
}
constexpr int VS = 136, PS = 264;
__device__ __forceinline__ void sgu_unit(const Frame& F, int nb, int h) {
    LAS bf16* Vt = (LAS bf16*)F.lds;
    const int lane = F.lane, w = F.wave, fr = lane & 15, fq = lane >> 4, t0 = nb * 128;
    const int nks = (w < 4) ? 2 : 4;
    bf16x8 Af[4];
#pragma unroll
    for (int ks = 0; ks < 4; ++ks) Af[ks] = *(const bf16x8*)(F.SGW + ((size_t)(h * 128 + 16 * w + fr) * 128 + (ks < nks ? ks : 0) * 32 + 8 * fq));
    LAS unsigned char* Us = F.lds + 34816;
    u32x4 ureg[4];
#pragma unroll
    for (int k = 0; k < 4; ++k) ureg[k] = *(const u32x4*)(F.UV + (size_t)(t0 + (F.tid >> 4) + 32 * k) * D + h * 128 + 8 * (F.tid & 15));
#pragma unroll
    for (int it = 0; it < 2; ++it) {
        const int idx = F.tid + NTHREADS * it, chunk = idx & 15, j = 2 * (idx >> 4);
        const bf16* src = F.UV + (size_t)(t0 + j) * D + DS + h * 128 + 8 * chunk;
        f32x4 a0, a1, b0, b1; unpack8(*(const u32x4*)src, a0, a1); unpack8(*(const u32x4*)(src + D), b0, b1);
        const float mu0 = F.vsum[t0 + j] * (1.f / DS), mu1 = F.vsum[t0 + j + 1] * (1.f / DS);
        const float rs0 = __builtin_amdgcn_rsqf(fmaxf(F.vsq[t0 + j] * (1.f / DS) - mu0 * mu0, 0.f) + EPS), rs1 = __builtin_amdgcn_rsqf(fmaxf(F.vsq[t0 + j + 1] * (1.f / DS) - mu1 * mu1, 0.f) + EPS);
        const f32x4 g0 = *(const f32x4*)(F.v_ln_g + h * 128 + 8 * chunk), g1 = *(const f32x4*)(F.v_ln_g + h * 128 + 8 * chunk + 4);
        const f32x4 c0 = *(const f32x4*)(F.v_ln_b + h * 128 + 8 * chunk), c1 = *(const f32x4*)(F.v_ln_b + h * 128 + 8 * chunk + 4);
        const f32x4 y00 = (a0 - mu0) * rs0 * g0 + c0, y01 = (a1 - mu0) * rs0 * g1 + c1, y10 = (b0 - mu1) * rs1 * g0 + c0, y11 = (b1 - mu1) * rs1 * g1 + c1;
#pragma unroll
        for (int q = 0; q < 4; ++q) { *(LAS unsigned*)(Vt + (8 * chunk + q) * VS + j) = cvt_pk_bf16(y00[q], y10[q]); *(LAS unsigned*)(Vt + (8 * chunk + 4 + q) * VS + j) = cvt_pk_bf16(y01[q], y11[q]); }
    }
#pragma unroll
    for (int k = 0; k < 4; ++k) *(LAS u32x4*)(Us + ((F.tid >> 4) + 32 * k) * 272 + (F.tid & 15) * 16) = ureg[k];
    __syncthreads();
    f32x4 acc[8];
#pragma unroll
    for (int nt = 0; nt < 8; ++nt) acc[nt] = (f32x4){0.f, 0.f, 0.f, 0.f};
#pragma unroll
    for (int ks = 0; ks < 4; ++ks) if (ks < nks) {
#pragma unroll
        for (int nt = 0; nt < 8; ++nt) { const bf16x8 Bf = *(const LAS bf16x8*)(Vt + (16 * nt + fr) * VS + 32 * ks + 8 * fq); acc[nt] = __builtin_amdgcn_mfma_f32_16x16x32_bf16(Bf, Af[ks], acc[nt], 0, 0, 0); } }
    const int i = 16 * w + fr; const float bias = F.sgu_b[h * 128 + i];
    LAS unsigned char* ost = F.lds + 69632 + w * 4352;
#pragma unroll
    for (int nt = 0; nt < 8; ++nt) { const u32x2 uu = *(const LAS u32x2*)(Us + i * 272 + (16 * nt + 4 * fq) * 2);
        u32x2 o; o.x = cvt_pk_bf16(bf_lo(uu.x) * (acc[nt][0] + bias), bf_hi(uu.x) * (acc[nt][1] + bias)); o.y = cvt_pk_bf16(bf_lo(uu.y) * (acc[nt][2] + bias), bf_hi(uu.y) * (acc[nt][3] + bias));
        *(LAS u32x2*)(ost + fr * 272 + (16 * nt + 4 * fq) * 2) = o; }
    asm volatile("s_waitcnt lgkmcnt(0)" ::: "memory");
#pragma unroll
    for (int k = 0; k < 4; ++k) { const int q = lane + 64 * k, row = q >> 4, ch = q & 15;
        st16_wt(F.YA + (size_t)(t0 + 16 * w + row) * DS + h * 128 + 8 * ch, *(const LAS u32x4*)(ost + row * 272 + ch * 16)); }
    __syncthreads();
}
template <int WIN>
__device__ __forceinline__ void pool_stage(const Frame& F, LAS bf16* Ap, int t0, int g) {
    const int chunk = F.tid & 31, tb = 8 * (F.tid >> 5), pos0 = (t0 & (SEQ - 1)) + tb;
    const bf16* src = F.P + (size_t)(t0 + tb) * DP + g * 256 + 8 * chunk;
    constexpr int NR = 8 + WIN - 1;
    u32x4 raw[NR];
#pragma unroll
    for (int r = 0; r < NR; ++r) { const int d = r - (WIN - 1);
        raw[r] = (pos0 + d >= 0) ? *(const u32x4*)(src + (ptrdiff_t)d * DP) : (u32x4){0u, 0u, 0u, 0u}; }
    f32x4 s0 = (f32x4){0.f, 0.f, 0.f, 0.f}, s1 = s0;
#pragma unroll
    for (int r = 0; r < WIN - 1; ++r) { f32x4 a, b; unpack8(raw[r], a, b); s0 += a; s1 += b; }
#pragma unroll
    for (int i = 0; i < 8; ++i) { f32x4 a, b; unpack8(raw[WIN - 1 + i], a, b); s0 += a; s1 += b;
        const int pos = pos0 + i; const float inv = 1.f / (float)((pos + 1 < WIN) ? pos + 1 : WIN);
        *(LAS u32x4*)(Ap + (tb + i) * PS + 8 * chunk) = pack8(s0 * inv - a, s1 * inv - b);
        f32x4 c, d; unpack8(raw[i], c, d); s0 -= c; s1 -= d; }
}
__device__ __forceinline__ void pool_unit(const Frame& F, int nb, int g) {
    LAS bf16* Ap = (LAS bf16*)F.lds;
    LAS unsigned char* Bs = F.lds + 67584;
    const int lane = F.lane, w = F.wave, fr = lane & 15, fq = lane >> 4, t0 = nb * 128;
    const bf16* Bsrc = F.PWT + (size_t)g * 65536 + (size_t)(F.tid >> 4) * 256 + 8 * (F.tid & 15);
    u32x4 breg[8];
#pragma unroll
    for (int i = 0; i < 8; ++i) breg[i] = *(const u32x4*)(Bsrc + (size_t)(32 * i) * 256);
    switch (g) { case 0: pool_stage<2>(F, Ap, t0, g); break; case 1: pool_stage<4>(F, Ap, t0, g); break; case 2: pool_stage<8>(F, Ap, t0, g); break; default: pool_stage<16>(F, Ap, t0, g); break; }
#pragma unroll
    for (int i = 0; i < 8; ++i) *(LAS u32x4*)(Bs + ((F.tid >> 4) + 32 * i) * 272 + (F.tid & 15) * 16) = breg[i];
    __syncthreads();
#pragma unroll
    for (int i = 0; i < 8; ++i) breg[i] = *(const u32x4*)(Bsrc + (size_t)(32 * i) * 256 + 128);
    const int wm = w >> 2, wn = w & 3;
    f32x4 acc[4][4];
#pragma unroll
    for (int a = 0; a < 4; ++a)
#pragma unroll
        for (int b = 0; b < 4; ++b) acc[a][b] = (f32x4){0.f, 0.f, 0.f, 0.f};
#pragma unroll
    for (int h = 0; h < 2; ++h) {
#pragma unroll
        for (int ks = 0; ks < 4; ++ks) {
            bf16x8 Af[4], Bf[4];
#pragma unroll
            for (int ni = 0; ni < 4; ++ni) Bf[ni] = *(const LAS bf16x8*)(Bs + (64 * wn + 16 * ni + fr) * 272 + (32 * ks + 8 * fq) * 2);
#pragma unroll
            for (int mi = 0; mi < 4; ++mi) Af[mi] = *(const LAS bf16x8*)(Ap + (64 * wm + 16 * mi + fr) * PS + 128 * h + 32 * ks + 8 * fq);
#pragma unroll
            for (int mi = 0; mi < 4; ++mi)
#pragma unroll
                for (int ni = 0; ni < 4; ++ni) acc[mi][ni] = __builtin_amdgcn_mfma_f32_16x16x32_bf16(Bf[ni], Af[mi], acc[mi][ni], 0, 0, 0);
        }
        __syncthreads();
        if (h == 0) {
#pragma unroll
            for (int i = 0; i < 8; ++i) *(LAS u32x4*)(Bs + ((F.tid >> 4) + 32 * i) * 272 + (F.tid & 15) * 16) = breg[i];
            __syncthreads(); }
    }
    LAS unsigned char* ost = F.lds + 67584 + w * 8704;
#pragma unroll
    for (int ni = 0; ni < 4; ++ni) { const int d = g * 256 + 64 * wn + 16 * ni + 4 * fq; const f32x4 sc = *(const f32x4*)(F.pool_scale + d);
#pragma unroll
        for (int mi = 0; mi < 4; ++mi) { const f32x4 o = acc[mi][ni] * sc; u32x2 wv; wv.x = cvt_pk_bf16(o[0], o[1]); wv.y = cvt_pk_bf16(o[2], o[3]);
            *(LAS u32x2*)(ost + (16 * mi + fr) * 136 + (16 * ni + 4 * fq) * 2) = wv; } }
    asm volatile("s_waitcnt lgkmcnt(0)" ::: "memory");
#pragma unroll
    for (int k = 0; k < 8; ++k) { const int q = lane + 64 * k, row = q >> 3, ch = q & 7;
        const LAS unsigned* p = (const LAS unsigned*)(ost + row * 136 + ch * 16);
        st16_wt(F.YB + (size_t)(t0 + 64 * wm + row) * DP + g * 256 + 64 * wn + 8 * ch, (u32x4){p[0], p[1], p[2], p[3]}); }
    __syncthreads();
}

__global__ void __launch_bounds__(NTHREADS, 2) mega_fwd(Args args) {
    extern __shared__ __attribute__((aligned(16))) unsigned char lds_raw[];
    cg::grid_group grid = cg::this_grid();
    Frame F;
    F.lds = (LAS unsigned char*)lds_raw; F.tid = threadIdx.x; F.lane = F.tid & 63; F.wave = __builtin_amdgcn_readfirstlane(F.tid >> 6); F.G = gridDim.x; F.bid = blockIdx.x;
    F.x = args.in[0]; F.norm1_pre = args.in[1]; F.w_in = args.in[2]; F.v_ln_g = args.in[3]; F.v_ln_b = args.in[4]; F.sgu_w = args.in[5]; F.sgu_b = args.in[6]; F.pool_w = args.in[7]; F.pool_scale = args.in[8];
    F.w_a = args.in[9]; F.w_b = args.in[10]; F.w_out = args.in[11]; F.norm1_post = args.in[12]; F.norm2_pre = args.in[13]; F.w_gate = args.in[14]; F.w_up = args.in[15]; F.w_down = args.in[16]; F.norm2_post = args.in[17];
    F.out = args.out; unsigned char* ws = args.ws;
    F.vsum = (float*)(ws + WS_STAT); F.vsq = F.vsum + M; F.st1 = F.vsum + 2 * M; F.st2 = F.vsum + 3 * M; F.st3 = F.vsum + 4 * M;
    F.WIN = (bf16*)(ws + WS_WIN); F.WAB = (bf16*)(ws + WS_WAB); F.WOUT = (bf16*)(ws + WS_WOUT); F.WGU = (bf16*)(ws + WS_WGU); F.WDN = (bf16*)(ws + WS_WDN); F.PWT = (bf16*)(ws + WS_PWT); F.SGW = (bf16*)(ws + WS_SGW);
    F.XN = (bf16*)(ws + WS_XN); F.XG = (bf16*)(ws + WS_XG); F.YA = F.XN; F.YB = F.XN + (size_t)M * DS; F.UV = (bf16*)(ws + WS_UV); F.MG = (bf16*)(ws + WS_XG);     F.P = (bf16*)(ws + WS_P); F.R = (bf16*)(ws + WS_R); F.GB = (bf16*)(ws + WS_GB); F.HID = (bf16*)(ws + WS_HID);

    if (F.tid < 16) ((LAS unsigned*)(F.lds + MISC_OFF))[F.tid] = 0u;
    __syncthreads();
    const XcdBarrier bar = xcd_barrier_post((unsigned*)(ws + WS_BAR), (volatile LAS unsigned*)(F.lds + MISC_OFF));
    if (args.out == nullptr) grid.sync();
    p0_prologue(F);
    if (PROBE_REP == 0) p0_prologue(F);
    if (PROBE_REP == 8) { for (int i = 0; i < 8; ++i) { xcd_barrier(bar); } }
    xcd_barrier(bar);
    constexpr int G1 = 224;
    unsigned* const tmo0 = (unsigned*)(ws + WS_BAR) + XB_TMO;
    unsigned* const lateW = (unsigned*)(ws + WS_BAR) + 30720;
    if (F.bid < G1) { pg8::Gemm g{F.XN, F.XN, F.WIN, F.WIN, M, DIN, D}; pg8::RangeOrder S; S.so.init(M, DIN, G1, F.bid);
      pg8::EpiIn E{F.UV, F.P, F.R, F.GB, F.vsum, F.vsq};
      S.base = 0; S.count = 2; pg8::gemm_phase<pg8::EpiIn, pg8::RangeOrder, true, true>(F.lds, g, S, E);
      if (F.tid == 0) { unsigned sp = 0; while (xb_ld(lateW) < (unsigned)((F.G - G1) * NWAVES)) { __builtin_amdgcn_s_sleep(1); if ((++sp & 255u) == 0u) { if (xb_ld(tmo0)) break; if (sp > XB_SPIN_CAP) { atomicAdd(tmo0, 1u); break; } } } }
      __syncthreads();
      S.base = 2; S.count = 2; pg8::gemm_phase<pg8::EpiIn, pg8::RangeOrder, true, true>(F.lds, g, S, E); }
    else { const int cw = (F.bid - G1) * NWAVES + F.wave, ncw = (F.G - G1) * NWAVES;
      convert_weights<3>(F, cw, ncw);
      asm volatile("s_waitcnt vmcnt(0)" ::: "memory"); if (F.lane == 0) (void)xb_add(lateW, 1u);
      convert_weights<1>(F, cw, ncw); }
    xcd_barrier(bar);
    pg8::Unit u0; { pg8::StaticOrder S0; S0.init(M, D, F.G, F.bid); S0.next(0, u0); }
    unsigned* const pwords = (unsigned*)(ws + WS_BAR) + PW_BASE + u0.pm * 64; unsigned* const tmo = (unsigned*)(ws + WS_BAR) + XB_TMO;
    for (int rep = 0; rep < (PROBE_REP == 2 ? 2 : 1); ++rep) {
        pool_unit(F, 2 * u0.pm + (u0.pn >> 2), u0.pn & 3);
        sgu_unit(F, 2 * u0.pm + (u0.pn >> 2), 2 * (u0.pn & 3)); sgu_unit(F, 2 * u0.pm + (u0.pn >> 2), 2 * (u0.pn & 3) + 1); }
    panel_barrier<false>(pwords + 0 * PW_SEAM, tmo);
    { pg8::Gemm g{F.YA, F.YB, F.WAB, F.WAB + (size_t)D * DS, M, D, DS}; pg8::PairOrder S; S.so.init(M, D, F.G, F.bid);
      pg8::EpiMerge E{F.R, F.GB, F.MG};
      if (PROBE_REP == 3) pg8::gemm_phase<pg8::EpiMerge, pg8::PairOrder, true, true>(F.lds, g, S, E);
      pg8::gemm_phase<pg8::EpiMerge, pg8::PairOrder, true, true>(F.lds, g, S, E); }
    panel_barrier<false>(pwords + 1 * PW_SEAM, tmo);
    { pg8::Gemm g{F.MG, F.MG, F.WOUT, F.WOUT, M, D, D}; pg8::StaticOrder S; S.init(M, D, F.G, F.bid);
      pg8::EpiNorm1 E{F.x, F.XG, F.norm1_post, F.st1, F.st2, pwords + 2 * PW_SEAM, tmo};
      if (PROBE_REP == 4) { pg8::EpiNull E0{(float*)(ws + WS_BAR + 131072)}; pg8::gemm_phase<pg8::EpiNull, pg8::StaticOrder, false, true>(F.lds, g, S, E0); }
      pg8::gemm_phase<pg8::EpiNorm1, pg8::StaticOrder, false, true>(F.lds, g, S, E); }
    xcd_barrier(bar);
    { pg8::Gemm g{F.XG, F.XG, F.WGU, F.WGU, M, 2 * FF, D}; pg8::IdxOrder S; S.so.init(M, 2 * FF, F.G, F.bid);
      LAS float* rsT = (LAS float*)(F.lds + 131072);
      if (F.tid < 256) { pg8::Unit uu; for (int i = 0; i < 8 && S.next(i, uu); ++i) rsT[i * 256 + F.tid] = __builtin_amdgcn_rsqf(F.st2[uu.pm * 256 + F.tid] * (1.f / D) + EPS); }
      __syncthreads();
      pg8::EpiSwiGLU E{F.HID, rsT};
      pg8::gemm_phase<pg8::EpiSwiGLU, pg8::IdxOrder, true, true>(F.lds, g, S, E); }
    { constexpr int U6 = (M / 256) * (2 * FF / 256), TAIL0 = U6 % 256;
      if (TAIL0 != 0 && F.bid >= TAIL0) convert_weights<2>(F, (F.bid - TAIL0) * NWAVES + F.wave, (F.G - TAIL0) * NWAVES);
      else if (TAIL0 == 0) convert_weights<2>(F, F.bid * NWAVES + F.wave, F.G * NWAVES); }
    xcd_barrier(bar);
    { pg8::Gemm g{F.HID, F.HID, F.WDN, F.WDN, M, D, FF}; pg8::StaticOrder S; S.init(M, D, F.G, F.bid);
      pg8::EpiNorm2 E{F.out, F.XG, F.norm2_post, F.st3, pwords + 3 * PW_SEAM, tmo};
      if (PROBE_REP == 7) { pg8::EpiNull E0{(float*)(ws + WS_BAR + 131072)}; pg8::gemm_phase<pg8::EpiNull, pg8::StaticOrder, false, true>(F.lds, g, S, E0); }
      pg8::gemm_phase<pg8::EpiNorm2, pg8::StaticOrder, false, true>(F.lds, g, S, E); }
}

extern "C" void kernel_launch(void* const* d_in, const int* in_sizes, int n_in, void* d_out, int out_size, void* d_ws, size_t ws_size, hipStream_t stream) {
    static int grid = 0;
    if (grid == 0) {
        if (n_in != 18 || in_sizes[0] != M * D || out_size != M * D || ws_size < WS_END) { fprintf(stderr, "kernel_launch: unexpected shapes (n_in %d, in0 %d, out %d, ws %zu); nothing launched\n", n_in, n_in > 0 ? in_sizes[0] : -1, out_size, ws_size); grid = -1; return; }
        int dev = 0, cus = 0, per_cu = 0;
        if (hipGetDevice(&dev) != hipSuccess || hipDeviceGetAttribute(&cus, hipDeviceAttributeMultiprocessorCount, dev) != hipSuccess) { grid = -1; return; }
        if (hipFuncSetAttribute((const void*)mega_fwd, hipFuncAttributeMaxDynamicSharedMemorySize, LDS_BYTES) != hipSuccess) { fprintf(stderr, "kernel_launch: hipFuncSetAttribute failed\n"); grid = -1; return; }
        if (hipOccupancyMaxActiveBlocksPerMultiprocessor(&per_cu, (const void*)mega_fwd, NTHREADS, LDS_BYTES) != hipSuccess || per_cu < 1) { fprintf(stderr, "kernel_launch: occupancy query reports %d blocks per CU\n", per_cu); (void)hipGetLastError(); grid = -1; return; }
        if (cus * per_cu < 256) { fprintf(stderr, "kernel_launch: needs 256 co-resident workgroups, device holds %d\n", cus * per_cu); grid = -1; return; }
        grid = 256;
    }
    if (grid < 0) return;
    Args a{};
    for (int i = 0; i < 18; ++i) a.in[i] = (const float*)d_in[i];
    a.out = (float*)d_out; a.ws = (unsigned char*)d_ws;
    if (hipMemsetAsync((char*)d_ws + WS_BAR, 0, 65536, stream) != hipSuccess) { fprintf(stderr, "kernel_launch: memset failed\n"); return; }
    void* kargs[] = {&a};
    hipError_t e = hipLaunchCooperativeKernel((const void*)mega_fwd, dim3(grid), dim3(NTHREADS), kargs, LDS_BYTES, stream);
    if (e != hipSuccess) fprintf(stderr, "kernel_launch: cooperative launch failed: %s\n", hipGetErrorString(e));
}
```
